# Optimizing an MI355X kernel written in HIP

```python
import math
import jax, jax.numpy as jnp
from jax import lax
import numpy as np

D_MODEL = 1024
BATCH = 16
SEQ = 2048
DEPTH = 1

HEAD_DIM = 64
GROUPS = ((128, 1), (512, 4), (2048, 16))
N_GROUPS = len(GROUPS)
HEADS_PER_GROUP = 8
N_HEADS = N_GROUPS * HEADS_PER_GROUP
ATTN_WIDTH = N_HEADS * HEAD_DIM
ATTN_OUT_WIDTH = HEADS_PER_GROUP * HEAD_DIM
Q_BLOCK = 128
CONV_WIDTH = D_MODEL
CONV_KERNEL = 31
N_BRANCHES = 2
D_FF = -(-8 * D_MODEL // (3 * 256)) * 256
IN_WIDTH = 3 * ATTN_WIDTH + 2 * CONV_WIDTH + N_BRANCHES * D_MODEL
RMS_EPS = 1e-6
LN_EPS = 1e-5

kernel_name = "hybrid_dilated_attn_conformer_conv_gated"


def _alibi_slope_list(n):
    def pow2(m):
        start = 2.0 ** (-8.0 / m)
        return [start ** (i + 1) for i in range(m)]
    if math.log2(n).is_integer():
        return pow2(n)
    c = 2 ** math.floor(math.log2(n))
    return pow2(c) + _alibi_slope_list(2 * c)[0::2][: n - c]


def _alibi_slopes():
    s = sorted(_alibi_slope_list(N_HEADS), reverse=True)
    return np.asarray(s, dtype=np.float32).reshape(N_GROUPS, HEADS_PER_GROUP)


def _rmsnorm(x, g):
    x32 = x.astype(jnp.float32)
    y = x32 * lax.rsqrt(jnp.mean(x32 * x32, axis=-1, keepdims=True) + RMS_EPS)
    return (y * g.astype(jnp.float32)).astype(x.dtype)


def _layernorm(x, g, b):
    x32 = x.astype(jnp.float32)
    mu = jnp.mean(x32, axis=-1, keepdims=True)
    var = jnp.mean(jnp.square(x32 - mu), axis=-1, keepdims=True)
    y = (x32 - mu) * lax.rsqrt(var + LN_EPS)
    return (y * g.astype(jnp.float32) + b.astype(jnp.float32)).astype(x.dtype)


def _dilated_group(q, k, v, slopes, window, dilation):
    B, S, Hg, hd = q.shape
    r = dilation
    L = S // r
    n_back = window // r
    assert n_back <= Q_BLOCK
    nb = -(-L // Q_BLOCK)
    Lp = nb * Q_BLOCK

    def to_sub(t):
        return t.reshape(B, L, r, Hg, hd).transpose(0, 2, 3, 1, 4)

    qb = jnp.pad(to_sub(q), ((0, 0), (0, 0), (0, 0), (0, Lp - L), (0, 0)))
    qb = qb.reshape(B, r, Hg, nb, Q_BLOCK, hd)

    def band(t):
        t = jnp.pad(to_sub(t), ((0, 0), (0, 0), (0, 0), (Q_BLOCK, Lp - L), (0, 0)))
        t = t.reshape(B, r, Hg, nb + 1, Q_BLOCK, hd)
        return jnp.concatenate([t[:, :, :, :-1], t[:, :, :, 1:]], axis=4)

    kb, vb = band(k), band(v)
    qi = jnp.arange(Q_BLOCK)[:, None]
    kj = jnp.arange(2 * Q_BLOCK)[None, :]
    rel = Q_BLOCK + qi - kj
    kpos = (jnp.arange(nb)[:, None, None] - 1) * Q_BLOCK + kj[None]
    valid = (rel >= 0) & (rel <= n_back) & (kpos >= 0)
    dist = (rel * r).astype(jnp.float32)

    s = jnp.einsum('brhnqd,brhnkd->brhnqk', qb, kb).astype(jnp.float32) * (hd ** -0.5)
    s = s - slopes.astype(jnp.float32)[:, None, None, None] * dist
    s = jnp.where(valid, s, -jnp.inf)
    m = jnp.max(s, axis=-1, keepdims=True)
    p = jnp.exp(s - m)
    denom = jnp.sum(p, axis=-1)
    o = jnp.einsum('brhnqk,brhnkd->brhnqd', p, vb.astype(jnp.float32)) / denom[..., None]
    lse = m[..., 0] + jnp.log(denom)

    o = o.reshape(B, r, Hg, Lp, hd)[:, :, :, :L].transpose(0, 3, 1, 2, 4).reshape(B, S, Hg, hd)
    lse = lse.reshape(B, r, Hg, Lp)[:, :, :, :L].transpose(0, 3, 1, 2).reshape(B, S, Hg)
    return o, lse


def _causal_depthwise_conv(u, w, b):
    C = u.shape[-1]
    y = lax.conv_general_dilated(
        u, w[:, None, :], window_strides=(1,), padding=[(CONV_KERNEL - 1, 0)],
        dimension_numbers=('NWC', 'WIO', 'NWC'), feature_group_count=C)
    return y + b


def setup_inputs(seed: int = 0) -> dict:
    key = jax.random.key(seed)
    ks = jax.random.split(key, 17)
    f32 = jnp.float32

    def w(k, shape, fan_in):
        return jax.random.normal(k, shape, f32) * (fan_in ** -0.5)

    def gain(k, shape):
        return 1.0 + 0.05 * jax.random.normal(k, shape, f32)

    D = DEPTH
    return {
        "x": jax.random.normal(ks[0], (BATCH, SEQ, D_MODEL), f32),
        "norm1_g": gain(ks[1], (D, D_MODEL)),
        "w_in": w(ks[2], (D, D_MODEL, IN_WIDTH), D_MODEL),
        "gate_b": 0.1 * jax.random.normal(ks[3], (D, N_BRANCHES * D_MODEL), f32),
        "conv_w": w(ks[4], (D, CONV_KERNEL, CONV_WIDTH), CONV_KERNEL),
        "conv_b": 0.02 * jax.random.normal(ks[5], (D, CONV_WIDTH), f32),
        "conv_ln_g": gain(ks[6], (D, CONV_WIDTH)),
        "conv_ln_b": 0.02 * jax.random.normal(ks[7], (D, CONV_WIDTH), f32),
        "w_conv_out": w(ks[8], (D, CONV_WIDTH, D_MODEL), CONV_WIDTH),
        "w_attn_out": w(ks[9], (D, ATTN_OUT_WIDTH, D_MODEL), ATTN_OUT_WIDTH),
        "w_o": w(ks[10], (D, D_MODEL, D_MODEL), D_MODEL),
        "norm2_g": gain(ks[11], (D, D_MODEL)),
        "w_ffn_gate": w(ks[12], (D, D_MODEL, D_FF), D_MODEL),
        "w_ffn_up": w(ks[13], (D, D_MODEL, D_FF), D_MODEL),
        "w_ffn_down": w(ks[14], (D, D_FF, D_MODEL), D_FF),
        "norm_f_g": gain(ks[15], (D_MODEL,)),
    }


def reference(x, norm1_g, w_in, gate_b, conv_w, conv_b, conv_ln_g, conv_ln_b,
              w_conv_out, w_attn_out, w_o, norm2_g, w_ffn_gate, w_ffn_up,
              w_ffn_down, norm_f_g):
    B, S, _ = x.shape
    slopes = jnp.asarray(_alibi_slopes())
    splits = [ATTN_WIDTH, 2 * ATTN_WIDTH, 3 * ATTN_WIDTH, 3 * ATTN_WIDTH + 2 * CONV_WIDTH]
    for l in range(DEPTH):
        h = _rmsnorm(x, norm1_g[l])
        proj = h @ w_in[l]
        q, k, v, u, g_logits = jnp.split(proj, splits, axis=-1)
        q = q.reshape(B, S, N_GROUPS, HEADS_PER_GROUP, HEAD_DIM)
        k = k.reshape(B, S, N_GROUPS, HEADS_PER_GROUP, HEAD_DIM)
        v = v.reshape(B, S, N_GROUPS, HEADS_PER_GROUP, HEAD_DIM)

        outs, lses = [], []
        for g, (window, dilation) in enumerate(GROUPS):
            o, lse = _dilated_group(q[:, :, g], k[:, :, g], v[:, :, g], slopes[g], window, dilation)
            outs.append(o)
            lses.append(lse)
        alpha = jax.nn.softmax(jnp.stack(lses, axis=0), axis=0)
        y_attn = jnp.sum(alpha[..., None] * jnp.stack(outs, axis=0), axis=0)
        y_attn = y_attn.reshape(B, S, ATTN_OUT_WIDTH).astype(x.dtype) @ w_attn_out[l]

        ua, ub = jnp.split(u, 2, axis=-1)
        c = ua * jax.nn.sigmoid(ub)
        c = _causal_depthwise_conv(c, conv_w[l], conv_b[l])
        c = jax.nn.silu(_layernorm(c, conv_ln_g[l], conv_ln_b[l]))
        y_conv = c @ w_conv_out[l]

        gates = jax.nn.sigmoid(g_logits + gate_b[l])
        g_attn, g_conv = jnp.split(gates, 2, axis=-1)
        x = x + (g_attn * y_attn + g_conv * y_conv) @ w_o[l]

        h2 = _rmsnorm(x, norm2_g[l])
        x = x + (jax.nn.silu(h2 @ w_ffn_gate[l]) * (h2 @ w_ffn_up[l])) @ w_ffn_down[l]
    return _rmsnorm(x, norm_f_g)
```

```cpp
#include <hip/hip_runtime.h>
#include <cstdint>
#include <cstdio>

typedef unsigned short bf16_t;
typedef short bf16x8 __attribute__((ext_vector_type(8)));
typedef float f32x4 __attribute__((ext_vector_type(4)));
typedef unsigned u32x4 __attribute__((ext_vector_type(4)));
typedef unsigned u32x2 __attribute__((ext_vector_type(2)));

constexpr int BATCH = 16, SEQ = 2048, D = 1024, M = BATCH * SEQ;
constexpr int AW = 1536, CW = 1024, FF = 2816, INW = 3 * AW + 2 * CW + 2 * D;
constexpr int NH = 24, HD = 64, KCONV = 31;
constexpr float RMS_EPS = 1e-6f, LN_EPS = 1e-5f;
constexpr float LOG2E = 1.4426950408889634f;
constexpr float C2 = 0.125f * LOG2E;

constexpr size_t MiB = 1u << 20;
constexpr size_t WS_CTL = 0;
constexpr size_t WS_WIN = 1 * MiB, WS_WA = 18 * MiB, WS_WC = 19 * MiB, WS_WO = 21 * MiB, WS_WGU = 23 * MiB, WS_WD = 34 * MiB;
constexpr size_t WS_SS1 = 40 * MiB, WS_SS2 = 42 * MiB, WS_LSE = 44 * MiB;
constexpr size_t WS_Q = 48 * MiB, WS_K = 144 * MiB, WS_V = 240 * MiB, WS_H = 336 * MiB, WS_C = 400 * MiB, WS_END = 464 * MiB;
constexpr size_t WS_ATT = WS_K, WS_ZA = WS_V, WS_HID = WS_Q, WS_C2 = WS_H, WS_X1B = WS_H, WS_Z = WS_C;

__device__ __forceinline__ unsigned f2bf(float f) { unsigned u = __builtin_bit_cast(unsigned, f); return (u + 0x7fffu + ((u >> 16) & 1u)) >> 16; }
__device__ __forceinline__ float bf2f(unsigned h) { return __builtin_bit_cast(float, h << 16); }
__device__ __forceinline__ float sigmoidf_(float x) { return 1.f / (1.f + __expf(-x)); }
__device__ __forceinline__ float wave_sum(float v) {
#pragma unroll
    for (int o = 1; o < 64; o <<= 1) v += __shfl_xor(v, o);
    return v;
}

__global__ void k_prep_w(const float* W, const float* W2, int K, int Nsrc, int Ndst, int mode, const float* ks, bf16_t* WT) {
    const size_t idx = (size_t)blockIdx.x * 256 + threadIdx.x;
    if (idx >= (size_t)Ndst * K) return;
    const int n = (int)(idx % Ndst), k = (int)(idx / Ndst);
    const float* src = W; int sn = n;
    if (mode == 1) {
        if (n >= 3 * AW && n < 3 * AW + 2 * CW) { const int u = n - 3 * AW, i = u >> 8, j = u & 255; sn = 3 * AW + (j < 128 ? 128 * i + j : CW + 128 * i + (j - 128)); }
    } else if (mode == 2) {
        const int i = n >> 8, j = n & 255; if (j < 128) sn = 128 * i + j; else { sn = 128 * i + (j - 128); src = W2; }
    }
    float v = src[(size_t)k * Nsrc + sn];
    if (ks) v *= ks[k];
    WT[(size_t)n * K + k] = (bf16_t)f2bf(v);
}

__global__ void k_rmsnorm_bf16(const float* x, const float* g, bf16_t* out) {
    const int row = blockIdx.x * 4 + (threadIdx.x >> 6), lane = threadIdx.x & 63;
    const f32x4* xr = (const f32x4*)(x + (size_t)row * D) + lane;
    f32x4 v[4]; float s = 0.f;
#pragma unroll
    for (int j = 0; j < 4; ++j) { v[j] = xr[64 * j]; s += (v[j].x * v[j].x + v[j].y * v[j].y) + (v[j].z * v[j].z + v[j].w * v[j].w); }
    const float r = 1.f / sqrtf(wave_sum(s) * (1.f / D) + RMS_EPS);
    u32x2* o = (u32x2*)(out + (size_t)row * D) + lane;
#pragma unroll
    for (int j = 0; j < 4; ++j) { const f32x4 gg = ((const f32x4*)g)[lane + 64 * j];
        u32x2 w; w.x = f2bf(v[j].x * r * gg.x) | (f2bf(v[j].y * r * gg.y) << 16); w.y = f2bf(v[j].z * r * gg.z) | (f2bf(v[j].w * r * gg.w) << 16); o[64 * j] = w; }
}

template <class Epi, bool DUAL>
__global__ __launch_bounds__(256) void k_gemm(const bf16_t* A, const bf16_t* Bt, int K, int boff, int pair, Epi e) {
    __shared__ __attribute__((aligned(16))) bf16_t sA[64][40];
    __shared__ __attribute__((aligned(16))) bf16_t sB[64][40];
    __shared__ __attribute__((aligned(16))) bf16_t sB2[64][40];
    const int tid = threadIdx.x, w = tid >> 6, lane = tid & 63;
    const int row0 = blockIdx.y * 64, col0 = blockIdx.x * 64;
    const int lr = tid >> 2, lc = (tid & 3) * 8;
    const int bc = col0 + lr, br = boff + (pair ? 256 * (bc >> 7) + (bc & 127) : bc);
    const bf16_t* ap = A + (size_t)(row0 + lr) * K + lc;
    const bf16_t* bp = Bt + (size_t)br * K + lc;
    const bf16_t* bp2 = bp + (size_t)128 * K;
    f32x4 acc[4], acc2[4];
#pragma unroll
    for (int n = 0; n < 4; ++n) { acc[n] = (f32x4){0.f, 0.f, 0.f, 0.f}; acc2[n] = (f32x4){0.f, 0.f, 0.f, 0.f}; }
    for (int k0 = 0; k0 < K; k0 += 32) {
        *(u32x4*)&sA[lr][lc] = *(const u32x4*)(ap + k0);
        *(u32x4*)&sB[lr][lc] = *(const u32x4*)(bp + k0);
        if (DUAL) *(u32x4*)&sB2[lr][lc] = *(const u32x4*)(bp2 + k0);
        __syncthreads();
        const bf16x8 a = *(const bf16x8*)&sA[w * 16 + (lane & 15)][(lane >> 4) * 8];
#pragma unroll
        for (int n = 0; n < 4; ++n) {
            const bf16x8 b = *(const bf16x8*)&sB[n * 16 + (lane & 15)][(lane >> 4) * 8];
            acc[n] = __builtin_amdgcn_mfma_f32_16x16x32_bf16(a, b, acc[n], 0, 0, 0);
            if (DUAL) { const bf16x8 b2 = *(const bf16x8*)&sB2[n * 16 + (lane & 15)][(lane >> 4) * 8];
                acc2[n] = __builtin_amdgcn_mfma_f32_16x16x32_bf16(a, b2, acc2[n], 0, 0, 0); }
        }
        __syncthreads();
    }
#pragma unroll
    for (int n = 0; n < 4; ++n)
#pragma unroll
        for (int j = 0; j < 4; ++j) e(row0 + w * 16 + (lane >> 4) * 4 + j, col0 + n * 16 + (lane & 15), acc[n][j], acc2[n][j]);
}

struct EpQKV { bf16_t* q;
    __device__ void operator()(int row, int col, float a, float) const { const int t = col / AW, c = col - t * AW;
        bf16_t* o = q + (size_t)t * ((WS_K - WS_Q) / 2); o[(size_t)row * AW + c] = (bf16_t)f2bf(t == 0 ? a * C2 : a); } };
struct EpGLU { bf16_t* c;
    __device__ void operator()(int row, int col, float a, float b) const { c[(size_t)row * CW + col] = (bf16_t)f2bf(a * sigmoidf_(b)); } };
struct EpGate { bf16_t* g; const float* gb;
    __device__ void operator()(int row, int col, float a, float) const { g[(size_t)row * 2048 + col] = (bf16_t)f2bf(sigmoidf_(a + gb[col])); } };
struct EpZA { const bf16_t* g; bf16_t* za;
    __device__ void operator()(int row, int col, float a, float) const { za[(size_t)row * D + col] = (bf16_t)f2bf(bf2f(g[(size_t)row * 2048 + col]) * a); } };
struct EpZ { const bf16_t* g; const bf16_t* za; bf16_t* z;
    __device__ void operator()(int row, int col, float a, float) const { z[(size_t)row * D + col] = (bf16_t)f2bf(bf2f(za[(size_t)row * D + col]) + bf2f(g[(size_t)row * 2048 + 1024 + col]) * a); } };
struct EpX1 { const float* x; float* x1; bf16_t* x1b;
    __device__ void operator()(int row, int col, float a, float) const { const float v = x[(size_t)row * D + col] + a; x1[(size_t)row * D + col] = v; x1b[(size_t)row * D + col] = (bf16_t)f2bf(v); } };
struct EpHid { const float* ss1; bf16_t* hid;
    __device__ void operator()(int row, int col, float a, float b) const { float s = 0.f;
#pragma unroll
        for (int i = 0; i < 16; ++i) s += ss1[(size_t)row * 16 + i];
        const float r = 1.f / sqrtf(s * (1.f / D) + RMS_EPS); const float gv = a * r, uv = b * r;
        hid[(size_t)row * FF + col] = (bf16_t)f2bf(gv * sigmoidf_(gv) * uv); } };
struct EpX2 { float* x;
    __device__ void operator()(int row, int col, float a, float) const { x[(size_t)row * D + col] += a; } };

__global__ void k_rowss(const float* x, float* ss) {
    const int row = blockIdx.x * 4 + (threadIdx.x >> 6), lane = threadIdx.x & 63;
    const f32x4* xr = (const f32x4*)(x + (size_t)row * D) + lane; float s = 0.f;
#pragma unroll
    for (int j = 0; j < 4; ++j) { const f32x4 v = xr[64 * j]; s += (v.x * v.x + v.y * v.y) + (v.z * v.z + v.w * v.w); }
    s = wave_sum(s);
    if (lane < 16) ss[(size_t)row * 16 + lane] = lane == 0 ? s : 0.f;
}
__global__ void k_final(float* x, const float* ss, const float* g) {
    const int row = blockIdx.x * 4 + (threadIdx.x >> 6), lane = threadIdx.x & 63;
    float s = 0.f;
#pragma unroll
    for (int i = 0; i < 16; ++i) s += ss[(size_t)row * 16 + i];
    const float r = 1.f / sqrtf(s * (1.f / D) + RMS_EPS);
    f32x4* xr = (f32x4*)(x + (size_t)row * D) + lane;
#pragma unroll
    for (int j = 0; j < 4; ++j) { f32x4 v = xr[64 * j]; const f32x4 gg = ((const f32x4*)g)[lane + 64 * j]; v.x *= r * gg.x; v.y *= r * gg.y; v.z *= r * gg.z; v.w *= r * gg.w; xr[64 * j] = v; }
}

__global__ __launch_bounds__(256) void k_attn_naive(bf16_t* Q, const bf16_t* Kb, const bf16_t* Vb, float* LSE) {
    const int idx = blockIdx.x * 256 + threadIdx.x;
    const int h = idx % NH, row = idx / NH, g = h >> 3, hh = h & 7;
    const int r = g == 0 ? 1 : (g == 1 ? 4 : 16);
    const int t = row % SEQ, i = t / r;
    const float ex = g == 0 ? -0.25f * (hh + 1) : (g == 1 ? -2.f - 0.25f * (hh + 1) : -4.f - 0.5f * (hh + 1));
    const float sl2 = exp2f(ex) * (float)r * LOG2E;
    float q[64], acc[64];
    bf16_t* qp = Q + (size_t)row * AW + h * 64;
#pragma unroll
    for (int d = 0; d < 64; ++d) { q[d] = bf2f(qp[d]); acc[d] = 0.f; }
    float m = -INFINITY, l = 0.f;
    const int nd = i < 128 ? i : 128;
    for (int dd = 0; dd <= nd; ++dd) {
        const size_t krow = (size_t)(row - r * dd);
        const bf16_t* kp = Kb + krow * AW + h * 64; const bf16_t* vp = Vb + krow * AW + h * 64;
        float s = 0.f;
#pragma unroll
        for (int d = 0; d < 64; ++d) s += q[d] * bf2f(kp[d]);
        s -= sl2 * (float)dd;
        if (s > m) { const float f = exp2f(m - s); l *= f;
#pragma unroll
            for (int d = 0; d < 64; ++d) acc[d] *= f;
            m = s; }
        const float p = exp2f(s - m); l += p;
#pragma unroll
        for (int d = 0; d < 64; ++d) acc[d] += p * bf2f(vp[d]);
    }
    const float il = 1.f / l;
#pragma unroll
    for (int d = 0; d < 64; ++d) qp[d] = (bf16_t)f2bf(acc[d] * il);
    LSE[(size_t)row * NH + h] = m + log2f(l);
}
__global__ void k_combine(const bf16_t* O, const float* LSE, bf16_t* ATT) {
    const int row = blockIdx.x * 4 + (threadIdx.x >> 6), lane = threadIdx.x & 63, hh = lane >> 3;
    const float l0 = LSE[(size_t)row * NH + hh], l1 = LSE[(size_t)row * NH + 8 + hh], l2 = LSE[(size_t)row * NH + 16 + hh];
    const float mx = fmaxf(l0, fmaxf(l1, l2));
    float a0 = exp2f(l0 - mx), a1 = exp2f(l1 - mx), a2 = exp2f(l2 - mx); const float inv = 1.f / (a0 + a1 + a2); a0 *= inv; a1 *= inv; a2 *= inv;
    const u32x4 v0 = *(const u32x4*)(O + (size_t)row * AW + lane * 8), v1 = *(const u32x4*)(O + (size_t)row * AW + 512 + lane * 8), v2 = *(const u32x4*)(O + (size_t)row * AW + 1024 + lane * 8);
    u32x4 o;
#pragma unroll
    for (int j = 0; j < 4; ++j) {
        const float lo = a0 * bf2f(v0[j] & 0xffffu) + a1 * bf2f(v1[j] & 0xffffu) + a2 * bf2f(v2[j] & 0xffffu);
        const float hi = a0 * bf2f(v0[j] >> 16) + a1 * bf2f(v1[j] >> 16) + a2 * bf2f(v2[j] >> 16);
        o[j] = f2bf(lo) | (f2bf(hi) << 16);
    }
    *(u32x4*)(ATT + (size_t)row * 512 + lane * 8) = o;
}
__global__ __launch_bounds__(256) void k_conv_naive(const bf16_t* C, const float* w, const float* cb, const float* lg, const float* lb, bf16_t* C2o) {
    __shared__ float red[8];
    const int row = blockIdx.x, t = row % SEQ, tid = threadIdx.x, ch = tid * 4;
    float y[4];
#pragma unroll
    for (int i = 0; i < 4; ++i) y[i] = cb[ch + i];
    for (int k = 0; k < KCONV; ++k) { const int tt = t - (KCONV - 1) + k; if (tt < 0) continue;
        const u32x2 xv = *(const u32x2*)(C + (size_t)(row - (KCONV - 1) + k) * CW + ch); const f32x4 wv = *(const f32x4*)(w + (size_t)k * CW + ch);
        y[0] += wv.x * bf2f(xv.x & 0xffffu); y[1] += wv.y * bf2f(xv.x >> 16); y[2] += wv.z * bf2f(xv.y & 0xffffu); y[3] += wv.w * bf2f(xv.y >> 16); }
    float s = wave_sum((y[0] + y[1]) + (y[2] + y[3]));
    if ((tid & 63) == 0) red[tid >> 6] = s;
    __syncthreads();
    const float mean = (red[0] + red[1] + red[2] + red[3]) * (1.f / CW);
    float q = 0.f;
#pragma unroll
    for (int i = 0; i < 4; ++i) { y[i] -= mean; q += y[i] * y[i]; }
    q = wave_sum(q);
    if ((tid & 63) == 0) red[4 + (tid >> 6)] = q;
    __syncthreads();
    const float rstd = 1.f / sqrtf((red[4] + red[5] + red[6] + red[7]) * (1.f / CW) + LN_EPS);
    float o[4];
#pragma unroll
    for (int i = 0; i < 4; ++i) { const float v = y[i] * rstd * lg[ch + i] + lb[ch + i]; o[i] = v * sigmoidf_(v); }
    u32x2 ov; ov.x = f2bf(o[0]) | (f2bf(o[1]) << 16); ov.y = f2bf(o[2]) | (f2bf(o[3]) << 16);
    *(u32x2*)(C2o + (size_t)row * CW + ch) = ov;
}

extern "C" void kernel_launch(void* const* d_in, const int* in_sizes, int n_in, void* d_out, int out_size, void* d_ws, size_t ws_size, hipStream_t stream) {
    if (n_in != 16 || out_size != M * D || ws_size < WS_END) { fprintf(stderr, "kernel_launch: unexpected shapes (n_in %d out %d ws %zu)\n", n_in, out_size, ws_size); return; }
    const float* x = (const float*)d_in[0]; const float* norm1_g = (const float*)d_in[1]; const float* w_in = (const float*)d_in[2]; const float* gate_b = (const float*)d_in[3];
    const float* conv_w = (const float*)d_in[4]; const float* conv_b = (const float*)d_in[5]; const float* ln_g = (const float*)d_in[6]; const float* ln_b = (const float*)d_in[7];
    const float* w_conv_out = (const float*)d_in[8]; const float* w_attn_out = (const float*)d_in[9]; const float* w_o = (const float*)d_in[10]; const float* norm2_g = (const float*)d_in[11];
    const float* w_gate = (const float*)d_in[12]; const float* w_up = (const float*)d_in[13]; const float* w_down = (const float*)d_in[14]; const float* norm_f_g = (const float*)d_in[15];
    unsigned char* ws = (unsigned char*)d_ws; float* out = (float*)d_out;
    bf16_t *Win = (bf16_t*)(ws + WS_WIN), *Wa = (bf16_t*)(ws + WS_WA), *Wc = (bf16_t*)(ws + WS_WC), *Wo = (bf16_t*)(ws + WS_WO), *Wgu = (bf16_t*)(ws + WS_WGU), *Wd = (bf16_t*)(ws + WS_WD);
    bf16_t *Qb = (bf16_t*)(ws + WS_Q), *Kb = (bf16_t*)(ws + WS_K), *Vb = (bf16_t*)(ws + WS_V), *Hb = (bf16_t*)(ws + WS_H), *Cb = (bf16_t*)(ws + WS_C);
    bf16_t *ATT = (bf16_t*)(ws + WS_ATT), *ZA = (bf16_t*)(ws + WS_ZA), *HID = (bf16_t*)(ws + WS_HID), *C2b = (bf16_t*)(ws + WS_C2), *X1B = (bf16_t*)(ws + WS_X1B), *Zb = (bf16_t*)(ws + WS_Z);
    float *SS1 = (float*)(ws + WS_SS1), *SS2 = (float*)(ws + WS_SS2), *LSE = (float*)(ws + WS_LSE);
    bf16_t* Gates = (bf16_t*)d_out;
    auto nb = [](size_t n) { return (unsigned)((n + 255) / 256); };
    k_prep_w<<<nb((size_t)INW * D), 256, 0, stream>>>(w_in, nullptr, D, INW, INW, 1, nullptr, Win);
    k_prep_w<<<nb((size_t)D * 512), 256, 0, stream>>>(w_attn_out, nullptr, 512, D, D, 0, nullptr, Wa);
    k_prep_w<<<nb((size_t)D * CW), 256, 0, stream>>>(w_conv_out, nullptr, CW, D, D, 0, nullptr, Wc);
    k_prep_w<<<nb((size_t)D * D), 256, 0, stream>>>(w_o, nullptr, D, D, D, 0, nullptr, Wo);
    k_prep_w<<<nb((size_t)2 * FF * D), 256, 0, stream>>>(w_gate, w_up, D, FF, 2 * FF, 2, norm2_g, Wgu);
    k_prep_w<<<nb((size_t)D * FF), 256, 0, stream>>>(w_down, nullptr, FF, D, D, 0, nullptr, Wd);
    k_rmsnorm_bf16<<<M / 4, 256, 0, stream>>>(x, norm1_g, Hb);
    k_gemm<EpQKV, false><<<dim3(3 * AW / 64, M / 64), 256, 0, stream>>>(Hb, Win, D, 0, 0, EpQKV{Qb});
    k_gemm<EpGLU, true><<<dim3(CW / 64, M / 64), 256, 0, stream>>>(Hb, Win, D, 3 * AW, 1, EpGLU{Cb});
    k_gemm<EpGate, false><<<dim3(2048 / 64, M / 64), 256, 0, stream>>>(Hb, Win, D, 3 * AW + 2 * CW, 0, EpGate{Gates, gate_b});
    k_attn_naive<<<M * NH / 256, 256, 0, stream>>>(Qb, Kb, Vb, LSE);
    k_conv_naive<<<M, 256, 0, stream>>>(Cb, conv_w, conv_b, ln_g, ln_b, C2b);
    k_combine<<<M / 4, 256, 0, stream>>>(Qb, LSE, ATT);
    k_gemm<EpZA, false><<<dim3(D / 64, M / 64), 256, 0, stream>>>(ATT, Wa, 512, 0, 0, EpZA{Gates, ZA});
    k_gemm<EpZ, false><<<dim3(D / 64, M / 64), 256, 0, stream>>>(C2b, Wc, CW, 0, 0, EpZ{Gates, ZA, Zb});
    k_gemm<EpX1, false><<<dim3(D / 64, M / 64), 256, 0, stream>>>(Zb, Wo, D, 0, 0, EpX1{x, out, X1B});
    k_rowss<<<M / 4, 256, 0, stream>>>(out, SS1);
    k_gemm<EpHid, true><<<dim3(FF / 64, M / 64), 256, 0, stream>>>(X1B, Wgu, D, 0, 1, EpHid{SS1, HID});
    k_gemm<EpX2, false><<<dim3(D / 64, M / 64), 256, 0, stream>>>(HID, Wd, FF, 0, 0, EpX2{out});
    k_rowss<<<M / 4, 256, 0, stream>>>(out, SS2);
    k_final<<<M / 4, 256, 0, stream>>>(out, SS2, norm_f_g);
}
```

```cpp
#include <hip/hip_runtime.h>
#include <cstdint>
#include <cstdio>

constexpr int BATCH = 16, SEQ = 2048, D = 1024, M = BATCH * SEQ;
constexpr int AW = 1536, CW = 1024, FF = 2816, INW = 3 * AW + 2 * CW + 2 * D;
constexpr int NH = 24, HD = 64, KCONV = 31;
constexpr float RMS_EPS = 1e-6f, LN_EPS = 1e-5f;
constexpr float LOG2E = 1.4426950408889634f;
constexpr float C2 = 0.125f * LOG2E;

constexpr size_t MiB = 1u << 20;
constexpr size_t WS_CTL = 0, CTL_ZERO_BYTES = 256 * 1024;
constexpr size_t WS_WIN = 1 * MiB, WS_WA = 18 * MiB, WS_WC = 19 * MiB, WS_WO = 21 * MiB, WS_WGU = 23 * MiB, WS_WD = 34 * MiB;
constexpr size_t WS_SS1 = 40 * MiB, WS_SS2 = 42 * MiB, WS_LSE = 44 * MiB;
constexpr size_t WS_Q = 48 * MiB, WS_K = 144 * MiB, WS_V = 240 * MiB, WS_H = 336 * MiB, WS_C = 400 * MiB, WS_END = 464 * MiB;
constexpr size_t WS_ATT = WS_K, WS_ZA = WS_V, WS_HID = WS_Q, WS_C2 = WS_H, WS_X1B = WS_H, WS_Z = WS_C;

namespace pg8 {
#define PG8_LAS __attribute__((address_space(3)))
typedef unsigned short bf16_t;
typedef short bf16x8 __attribute__((ext_vector_type(8)));
typedef float f32x4 __attribute__((ext_vector_type(4)));
typedef unsigned u32x4 __attribute__((ext_vector_type(4)));
constexpr int BM = 256, BK = 64, HALF = 128, HTB = HALF * BK * 2  , STAGE_BYTES = 8 * HTB, NXCD = 8, WGM = 8;

__host__ __device__ __forceinline__ int lds_byte(int r, int c) { const int st = (r >> 4) * 2 + (c >> 5), rr = r & 15, cc = c & 31, ob = rr * 64 + cc * 2; return st * 1024 + (ob ^ (((ob >> 9) & 1) << 5)); }
__host__ __device__ __forceinline__ void stage_rc(int b, int& R, int& C) { const int st = b / 1024, sb = b % 1024, swz = sb ^ (((sb >> 9) & 1) << 5); R = (st >> 1) * 16 + swz / 64; C = (st & 1) * 32 + (swz % 64) / 2; }
__host__ __device__ __forceinline__ int perm32(int rho) { const int n = rho >> 4, i = rho & 15; return 8 * (i >> 2) + 4 * n + (i & 3); }

struct Unit { int pm, pn; };
struct Gemm { const bf16_t* A; const bf16_t* Bt; int M, N, K; };

struct StaticOrder {
    int nM, nN, nwg, G, c;
    __host__ __device__ void init(int M, int N, int G_, int c_) { nM = M / BM; nN = N / BM; nwg = nM * nN; G = G_; c = c_; }
    __host__ __device__ bool next(int i, Unit& u) const {
        const long L = (long)i * G + c; if (L >= nwg) return false;
        int wgid = (int)L; { const int q = nwg / NXCD, r = nwg % NXCD, xcd = wgid % NXCD, off = wgid / NXCD; wgid = (xcd < r ? xcd * (q + 1) : r * (q + 1) + (xcd - r) * q) + off; }
        const int nig = WGM * nN, gid = wgid / nig, fm = gid * WGM, gsz = (nM - fm) < WGM ? (nM - fm) : WGM;
        u.pm = fm + ((wgid % nig) % gsz); u.pn = (wgid % nig) / gsz; return true;
    }
    __device__ __forceinline__ void a_ready(const Unit&) const {}
    __device__ __forceinline__ void done(const Unit&) const {}
};

typedef float f32x2e __attribute__((ext_vector_type(2))); typedef __bf16 bf16x2e __attribute__((ext_vector_type(2)));
__device__ __forceinline__ unsigned cvt_pk_bf16(float lo, float hi) { f32x2e v = {lo, hi}; bf16x2e b = __builtin_convertvector(v, bf16x2e); return __builtin_bit_cast(unsigned, b); }
typedef unsigned u32x2 __attribute__((ext_vector_type(2)));
__device__ __forceinline__ float sigm(float x) { return __builtin_amdgcn_rcpf(1.f + __builtin_amdgcn_exp2f(-1.4426950408889634f * x)); }
__device__ __forceinline__ f32x4 sigm4(f32x4 v) { return (f32x4){sigm(v[0]), sigm(v[1]), sigm(v[2]), sigm(v[3])}; }
__device__ __forceinline__ u32x4 pack8(f32x4 v0, f32x4 v1) { u32x4 w; w.x = cvt_pk_bf16(v0[0], v0[1]); w.y = cvt_pk_bf16(v0[2], v0[3]); w.z = cvt_pk_bf16(v1[0], v1[1]); w.w = cvt_pk_bf16(v1[2], v1[3]); return w; }
__device__ __forceinline__ f32x4 unlo(u32x4 w) { return (f32x4){__builtin_bit_cast(float, w.x << 16), __builtin_bit_cast(float, w.x & 0xffff0000u), __builtin_bit_cast(float, w.y << 16), __builtin_bit_cast(float, w.y & 0xffff0000u)}; }
__device__ __forceinline__ f32x4 unhi(u32x4 w) { return (f32x4){__builtin_bit_cast(float, w.z << 16), __builtin_bit_cast(float, w.z & 0xffff0000u), __builtin_bit_cast(float, w.w << 16), __builtin_bit_cast(float, w.w & 0xffff0000u)}; }

struct EpiIn {
    static constexpr bool PERM = true, AFTER_DRAIN = false;
    bf16_t* Q; bf16_t* C; bf16_t* G; const float* gate_b; size_t qstride;
    __device__ __forceinline__ void operator()(const f32x4 (&acc)[2][2][4][2], const Unit& u, int wr, int wc, int fr, int fq) const {
        const int row0 = u.pm * BM + wr * 64 + fr, cl = wc * 32 + 8 * fq;
        if (u.pn < 18) {
            const int t = u.pn / 6; bf16_t* base = Q + (size_t)t * qstride + (u.pn - 6 * t) * 256 + cl; const float sc = (t == 0) ? C2 : 1.f;
#pragma unroll
            for (int ai = 0; ai < 2; ++ai)
#pragma unroll
                for (int m = 0; m < 4; ++m) { bf16_t* rowp = base + (size_t)(row0 + ai * HALF + m * 16) * AW;
#pragma unroll
                    for (int bj = 0; bj < 2; ++bj) *(u32x4*)(rowp + bj * HALF) = pack8(acc[ai][bj][m][0] * sc, acc[ai][bj][m][1] * sc); }
        } else if (u.pn < 26) {
            bf16_t* base = C + (u.pn - 18) * 128 + cl;
#pragma unroll
            for (int ai = 0; ai < 2; ++ai)
#pragma unroll
                for (int m = 0; m < 4; ++m) { bf16_t* rowp = base + (size_t)(row0 + ai * HALF + m * 16) * CW;
                    *(u32x4*)rowp = pack8(acc[ai][0][m][0] * sigm4(acc[ai][1][m][0]), acc[ai][0][m][1] * sigm4(acc[ai][1][m][1])); }
        } else {
            const int colt = (u.pn - 26) * 256 + cl; f32x4 gb[2][2];
#pragma unroll
            for (int bj = 0; bj < 2; ++bj)
#pragma unroll
                for (int n = 0; n < 2; ++n) gb[bj][n] = *(const f32x4*)(gate_b + colt + bj * HALF + 4 * n);
#pragma unroll
            for (int ai = 0; ai < 2; ++ai)
#pragma unroll
                for (int m = 0; m < 4; ++m) { bf16_t* rowp = G + (size_t)(row0 + ai * HALF + m * 16) * 2048 + colt;
#pragma unroll
                    for (int bj = 0; bj < 2; ++bj) *(u32x4*)(rowp + bj * HALF) = pack8(sigm4(acc[ai][bj][m][0] + gb[bj][0]), sigm4(acc[ai][bj][m][1] + gb[bj][1])); }
        }
    }
};
template <int MODE> struct EpiMerge {
    static constexpr bool PERM = true, AFTER_DRAIN = false;
    const bf16_t* G; const bf16_t* ZAin; bf16_t* O;
    __device__ __forceinline__ void operator()(const f32x4 (&acc)[2][2][4][2], const Unit& u, int wr, int wc, int fr, int fq) const {
        const int row0 = u.pm * BM + wr * 64 + fr, col0 = u.pn * BM + wc * 32 + 8 * fq;
#pragma unroll
        for (int ai = 0; ai < 2; ++ai)
#pragma unroll
            for (int m = 0; m < 4; ++m) { const size_t row = (size_t)(row0 + ai * HALF + m * 16);
#pragma unroll
                for (int bj = 0; bj < 2; ++bj) { const int col = col0 + bj * HALF;
                    const u32x4 g = *(const u32x4*)(G + row * 2048 + MODE * 1024 + col);
                    f32x4 v0 = unlo(g) * acc[ai][bj][m][0], v1 = unhi(g) * acc[ai][bj][m][1];
                    if (MODE == 1) { const u32x4 z = *(const u32x4*)(ZAin + row * D + col); v0 += unlo(z); v1 += unhi(z); }
                    *(u32x4*)(O + row * D + col) = pack8(v0, v1); } }
    }
};
template <bool WB> struct EpiRes {
    static constexpr bool PERM = false, AFTER_DRAIN = false;
    const float* xin; float* xo; bf16_t* xb; float* ss;
    __device__ __forceinline__ void operator()(const f32x4 (&acc)[2][2][4][2], const Unit& u, int wr, int wc, int fr, int fq) const {
        const int row0 = u.pm * BM + wr * 64 + fr, col0 = u.pn * BM + wc * 32 + 4 * fq;
#pragma unroll
        for (int ai = 0; ai < 2; ++ai)
#pragma unroll
            for (int m = 0; m < 4; ++m) { const size_t row = (size_t)(row0 + ai * HALF + m * 16), off = row * D + col0; float s = 0.f;
#pragma unroll
                for (int bj = 0; bj < 2; ++bj)
#pragma unroll
                    for (int n = 0; n < 2; ++n) { const size_t o2 = off + bj * HALF + n * 16; const f32x4 v = *(const f32x4*)(xin + o2) + acc[ai][bj][m][n];
                        *(f32x4*)(xo + o2) = v; s += (v[0] * v[0] + v[1] * v[1]) + (v[2] * v[2] + v[3] * v[3]);
                        if (WB) { u32x2 w; w.x = cvt_pk_bf16(v[0], v[1]); w.y = cvt_pk_bf16(v[2], v[3]); *(u32x2*)(xb + o2) = w; } }
                s += __shfl_xor(s, 16); s += __shfl_xor(s, 32);
                if (fq == 0) ss[row * 16 + u.pn * 4 + wc] = s;
                if (m & 1) asm volatile("" ::: "memory"); }
    }
};
struct EpiHid {
    static constexpr bool PERM = true, AFTER_DRAIN = false;
    const float* ss; bf16_t* hid;
    __device__ __forceinline__ void operator()(const f32x4 (&acc)[2][2][4][2], const Unit& u, int wr, int wc, int fr, int fq) const {
        const int row0 = u.pm * BM + wr * 64 + fr, cl = u.pn * 128 + wc * 32 + 8 * fq;
#pragma unroll
        for (int ai = 0; ai < 2; ++ai)
#pragma unroll
            for (int m = 0; m < 4; ++m) { const size_t row = (size_t)(row0 + ai * HALF + m * 16);
                const f32x4* sp = (const f32x4*)(ss + row * 16); const f32x4 s4 = (sp[0] + sp[1]) + (sp[2] + sp[3]);
                const float r = __builtin_amdgcn_rsqf(((s4[0] + s4[1]) + (s4[2] + s4[3])) * (1.f / D) + RMS_EPS);
                const f32x4 g0 = acc[ai][0][m][0] * r, g1 = acc[ai][0][m][1] * r, u0 = acc[ai][1][m][0] * r, u1 = acc[ai][1][m][1] * r;
                *(u32x4*)(hid + row * FF + cl) = pack8(g0 * sigm4(g0) * u0, g1 * sigm4(g1) * u1); }
    }
};

template <class Epi, class Sched, bool ALIGN_EPI = false, bool SP2 = false>
__device__ __forceinline__ void gemm_phase(PG8_LAS unsigned char* lds, const Gemm g, const Sched& S, const Epi& E) {
    const int tid = threadIdx.x, wid = __builtin_amdgcn_readfirstlane(tid >> 6), lane = tid & 63, wr = wid >> 2, wc = wid & 3, fr = lane & 15, fq = lane >> 4;
    const int K = g.K, nt = K / BK;
    unsigned voffA[2], voffB[2];
#pragma unroll
    for (int i = 0; i < 2; ++i) { int R, C; stage_rc(tid * 16 + i * 8192, R, C); const int Rb = Epi::PERM ? ((R & ~31) + perm32(R & 31)) : R;
        voffA[i] = (unsigned)(R * K + C) * 2u; voffB[i] = (unsigned)(Rb * K + C) * 2u; }
    const size_t kstep = (size_t)(BK * 2);
    const size_t hstep = (size_t)HALF * K * 2;
    const size_t tstep = 2 * hstep;
    const unsigned ldsw = (unsigned)wid * 1024u;
    const int aoff = lds_byte(wr * 64 + fr, fq * 8), boff = lds_byte(wc * 32 + fr, fq * 8);
#define PG8_SA(b, h) (((b) * 2 + (h)) * HTB)
#define PG8_SB(b, h) ((4 + (b) * 2 + (h)) * HTB)
#define PG8_STAGE(bufoff, gbase, voff) do { _Pragma("unroll") for (int _i = 0; _i < 2; ++_i) \
        __builtin_amdgcn_global_load_lds((const unsigned*)((const char*)(gbase) + (voff)[_i]), (PG8_LAS unsigned*)(lds + (bufoff) + ldsw + _i * 8192), 16, 0, 0); } while (0)
#define PG8_LDA(dst, b, h) do { _Pragma("unroll") for (int m = 0; m < 4; ++m) _Pragma("unroll") for (int k = 0; k < 2; ++k) dst[m][k] = *(const PG8_LAS bf16x8*)(lds + PG8_SA(b, h) + aoff + m * 2048 + k * 1024); } while (0)
#define PG8_LDB(dst, b, h) do { _Pragma("unroll") for (int n = 0; n < 2; ++n) _Pragma("unroll") for (int k = 0; k < 2; ++k) dst[n][k] = *(const PG8_LAS bf16x8*)(lds + PG8_SB(b, h) + boff + n * 2048 + k * 1024); } while (0)
#define PG8_MMA(ai, bj, At, Bt) do { __builtin_amdgcn_s_setprio(1); _Pragma("unroll") for (int m = 0; m < 4; ++m) _Pragma("unroll") for (int n = 0; n < 2; ++n) _Pragma("unroll") for (int k = 0; k < 2; ++k) \
        acc[ai][bj][m][n] = __builtin_amdgcn_mfma_f32_16x16x32_bf16(Bt[n][k], At[m][k], acc[ai][bj][m][n], 0, 0, 0); __builtin_amdgcn_s_setprio(0); } while (0)
#define PG8_WAIT_V(n) asm volatile("s_waitcnt vmcnt(" #n ")" ::: "memory")
#define PG8_WAIT_L(n) asm volatile("s_waitcnt lgkmcnt(" #n ")" ::: "memory")
#define PG8_BAR __builtin_amdgcn_s_barrier()
#define PG8_SCHED __builtin_amdgcn_sched_barrier(0)
    Unit cur, nxt; int ui = 0;
    if (!S.next(0, cur)) return;
    f32x4 acc[2][2][4][2];
#pragma unroll
    for (int a = 0; a < 2; ++a)
#pragma unroll
        for (int b = 0; b < 2; ++b)
#pragma unroll
            for (int m = 0; m < 4; ++m)
#pragma unroll
                for (int n = 0; n < 2; ++n) acc[a][b][m][n] = (f32x4){0.f, 0.f, 0.f, 0.f};
    bf16x8 At[4][2], B0[2][2], B1[2][2];
    const char* cA = (const char*)g.A + (size_t)cur.pm * tstep; const char* cB = (const char*)g.Bt + (size_t)cur.pn * tstep;
    S.a_ready(cur);
    if constexpr (SP2) {
        PG8_STAGE(PG8_SB(0, 0), cB, voffB); PG8_STAGE(PG8_SB(0, 1), cB + hstep, voffB); PG8_STAGE(PG8_SA(0, 0), cA, voffA); PG8_STAGE(PG8_SA(0, 1), cA + hstep, voffA);
        if (wr == 1) PG8_BAR;
        PG8_WAIT_V(2); PG8_BAR;
        PG8_STAGE(PG8_SB(1, 0), cB + kstep, voffB); PG8_STAGE(PG8_SA(1, 0), cA + kstep, voffA); PG8_STAGE(PG8_SB(1, 1), cB + hstep + kstep, voffB);
        PG8_WAIT_V(6); PG8_BAR;
    } else {
        PG8_STAGE(PG8_SB(0, 0), cB, voffB); PG8_STAGE(PG8_SA(0, 0), cA, voffA); PG8_STAGE(PG8_SB(0, 1), cB + hstep, voffB); PG8_STAGE(PG8_SA(0, 1), cA + hstep, voffA);
        if (wr == 1) PG8_BAR;
        PG8_WAIT_V(4); PG8_BAR;
        PG8_STAGE(PG8_SB(1, 0), cB + kstep, voffB); PG8_STAGE(PG8_SA(1, 0), cA + kstep, voffA); PG8_STAGE(PG8_SB(1, 1), cB + hstep + kstep, voffB);
        PG8_WAIT_V(6); PG8_BAR;
    }
    for (;;) {
        const bool has_next = S.next(ui + 1, nxt);
        const char* nA = has_next ? (const char*)g.A + (size_t)nxt.pm * tstep : cA; const char* nB = has_next ? (const char*)g.Bt + (size_t)nxt.pn * tstep : cB;
        for (int t = 0; t < nt; t += 2) {
            const bool last = (t == nt - 2);
            const char* a1 = cA + (size_t)(t + 1) * kstep;
            const char* a2 = last ? nA : cA + (size_t)(t + 2) * kstep; const char* b2 = last ? nB : cB + (size_t)(t + 2) * kstep;
            const char* a3 = a2 + kstep; const char* b3 = b2 + kstep;
            if (last && has_next) S.a_ready(nxt);
            if constexpr (SP2) {
            PG8_LDB(B0, 0, 0); PG8_LDB(B1, 0, 1); PG8_SCHED; PG8_LDA(At, 0, 0); PG8_STAGE(PG8_SA(1, 1), a1 + hstep, voffA);
            PG8_WAIT_V(8); PG8_WAIT_L(0); PG8_BAR; PG8_MMA(0, 0, At, B0); PG8_MMA(0, 1, At, B1); PG8_BAR; PG8_SCHED;
            PG8_LDA(At, 0, 1); PG8_STAGE(PG8_SB(0, 0), b2, voffB); PG8_STAGE(PG8_SB(0, 1), b2 + hstep, voffB); PG8_STAGE(PG8_SA(0, 0), a2, voffA);
            PG8_WAIT_V(8); PG8_WAIT_L(0); PG8_BAR; PG8_MMA(1, 0, At, B0); PG8_MMA(1, 1, At, B1); PG8_BAR; PG8_SCHED;
            PG8_LDB(B0, 1, 0); PG8_LDB(B1, 1, 1); PG8_SCHED; PG8_LDA(At, 1, 0); PG8_STAGE(PG8_SA(0, 1), a2 + hstep, voffA);
            PG8_WAIT_V(8); PG8_WAIT_L(0); PG8_BAR; PG8_MMA(0, 0, At, B0); PG8_MMA(0, 1, At, B1); PG8_BAR; PG8_SCHED;
            PG8_LDA(At, 1, 1); PG8_STAGE(PG8_SB(1, 0), b3, voffB); PG8_STAGE(PG8_SB(1, 1), b3 + hstep, voffB); PG8_STAGE(PG8_SA(1, 0), a3, voffA);
            PG8_WAIT_V(8); PG8_WAIT_L(0); PG8_BAR; PG8_MMA(1, 0, At, B0); PG8_MMA(1, 1, At, B1); PG8_BAR; PG8_SCHED;
            } else {
            PG8_LDB(B0, 0, 0); PG8_SCHED; PG8_LDA(At, 0, 0); PG8_STAGE(PG8_SA(1, 1), a1 + hstep, voffA);
            PG8_WAIT_L(8); PG8_BAR; PG8_WAIT_L(0); PG8_MMA(0, 0, At, B0); PG8_BAR; PG8_SCHED;
            PG8_LDB(B1, 0, 1); PG8_STAGE(PG8_SB(0, 0), b2, voffB);
            PG8_BAR; PG8_WAIT_L(0); PG8_MMA(0, 1, At, B1); PG8_BAR;
            PG8_LDA(At, 0, 1); PG8_STAGE(PG8_SA(0, 0), a2, voffA);
            PG8_BAR; PG8_WAIT_L(0); PG8_MMA(1, 0, At, B0); PG8_BAR; PG8_SCHED;
            PG8_STAGE(PG8_SB(0, 1), b2 + hstep, voffB);
            PG8_WAIT_V(6); PG8_BAR; PG8_MMA(1, 1, At, B1); PG8_BAR;
            PG8_LDB(B0, 1, 0); PG8_SCHED; PG8_LDA(At, 1, 0); PG8_STAGE(PG8_SA(0, 1), a2 + hstep, voffA);
            PG8_WAIT_L(8); PG8_BAR; PG8_WAIT_L(0); PG8_MMA(0, 0, At, B0); PG8_BAR; PG8_SCHED;
            PG8_LDB(B1, 1, 1); PG8_STAGE(PG8_SB(1, 0), b3, voffB);
            PG8_BAR; PG8_WAIT_L(0); PG8_MMA(0, 1, At, B1); PG8_BAR;
            PG8_LDA(At, 1, 1); PG8_STAGE(PG8_SA(1, 0), a3, voffA);
            PG8_BAR; PG8_WAIT_L(0); PG8_MMA(1, 0, At, B0); PG8_BAR; PG8_SCHED;
            PG8_STAGE(PG8_SB(1, 1), b3 + hstep, voffB);
            PG8_WAIT_V(6); PG8_BAR; PG8_MMA(1, 1, At, B1); PG8_BAR;
            }
        }
        if constexpr (ALIGN_EPI) { if (wr == 0) PG8_BAR; }
        if constexpr (!Epi::AFTER_DRAIN) { E(acc, cur, wr, wc, fr, fq); S.done(cur); }
        if (!has_next) break;
#pragma unroll
        for (int a = 0; a < 2; ++a)
#pragma unroll
            for (int b = 0; b < 2; ++b)
#pragma unroll
                for (int m = 0; m < 4; ++m)
#pragma unroll
                    for (int n = 0; n < 2; ++n) acc[a][b][m][n] = (f32x4){0.f, 0.f, 0.f, 0.f};
        cur = nxt; cA = nA; cB = nB; ++ui;
        if constexpr (ALIGN_EPI) { if (wr == 1) PG8_BAR; }
    }
    PG8_WAIT_V(0);
    if constexpr (!ALIGN_EPI) { if (wr == 0) PG8_BAR; }
    PG8_BAR;
    if constexpr (Epi::AFTER_DRAIN) { E.fused(acc, cur, wr, wc, fr, fq, lds, wid, lane); S.done(cur); }
#undef PG8_SA
#undef PG8_SB
#undef PG8_STAGE
#undef PG8_LDA
#undef PG8_LDB
#undef PG8_MMA
#undef PG8_WAIT_V
#undef PG8_WAIT_L
#undef PG8_BAR
#undef PG8_SCHED
}
}
#define GAS __attribute__((address_space(1)))
#define LAS __attribute__((address_space(3)))
typedef unsigned short bf16;
typedef unsigned v4u __attribute__((ext_vector_type(4)));
typedef unsigned v2u __attribute__((ext_vector_type(2)));
typedef float f32x4 __attribute__((ext_vector_type(4)));
typedef float f32x2 __attribute__((ext_vector_type(2)));
typedef float f32x16 __attribute__((ext_vector_type(16)));
typedef short bf16x8 __attribute__((ext_vector_type(8)));
typedef short s16x4 __attribute__((ext_vector_type(4)));
typedef GAS unsigned gu32;
#define RLX_AGENT __ATOMIC_RELAXED, __HIP_MEMORY_SCOPE_AGENT
#define LDS_WAIT() asm volatile("s_waitcnt lgkmcnt(0)" ::: "memory")
#define VM_WAIT() asm volatile("s_waitcnt vmcnt(0)" ::: "memory")
__device__ __forceinline__ unsigned f2bf(float f) { unsigned u = __builtin_bit_cast(unsigned, f); return (u + 0x7fffu + ((u >> 16) & 1u)) >> 16; }
__device__ __forceinline__ unsigned pk2(float lo, float hi) { return f2bf(lo) | (f2bf(hi) << 16); }
__device__ __forceinline__ float bf2f(unsigned h) { return __builtin_bit_cast(float, h << 16); }
__device__ __forceinline__ float bflo(unsigned w) { return __builtin_bit_cast(float, w << 16); }
__device__ __forceinline__ float bfhi(unsigned w) { return __builtin_bit_cast(float, w & 0xffff0000u); }
__device__ __forceinline__ float sigmoidf_(float x) { return 1.f / (1.f + __expf(-x)); }
__device__ __forceinline__ float sigm_fast(float x) { return __builtin_amdgcn_rcpf(1.f + __builtin_amdgcn_exp2f(-LOG2E * x)); }
__device__ __forceinline__ float wave_sum(float v) {
#pragma unroll
    for (int o = 1; o < 64; o <<= 1) v += __shfl_xor(v, o);
    return v;
}

constexpr int RING_OFF = 0, RING_BYTES = 131072;
constexpr int OST_OFF = RING_BYTES, OSTW = 2304, OST_BYTES = 8 * OSTW;
constexpr int LDSCTL_OFF = OST_OFF + OST_BYTES, MISC_OFF = LDSCTL_OFF + 320;
constexpr int LDS_BYTES = LDSCTL_OFF + 512;
static_assert(MISC_OFF + 128 <= LDS_BYTES, "LDS map");

__device__ __forceinline__ void p0_transpose_item(const float* W, int K, int Nsrc, int scol, bf16* WT, int drow, int k0, const float* ks, LAS float* scr, int lane) {
#pragma unroll 8
    for (int i = 0; i < 32; ++i) { const int kk = 2 * i + (lane >> 5); float v = W[(size_t)(k0 + kk) * Nsrc + scol + (lane & 31)]; if (ks) v *= ks[k0 + kk]; scr[kk * 33 + (lane & 31)] = v; }
    LDS_WAIT(); asm volatile("" ::: "memory");
    const int c = lane & 7;
#pragma unroll
    for (int j = 0; j < 4; ++j) { const int n = (lane >> 3) + 8 * j; const LAS float* s = scr + (8 * c) * 33 + n;
        v4u o; o.x = pk2(s[0 * 33], s[1 * 33]); o.y = pk2(s[2 * 33], s[3 * 33]); o.z = pk2(s[4 * 33], s[5 * 33]); o.w = pk2(s[6 * 33], s[7 * 33]);
        *(GAS v4u*)(WT + (size_t)(drow + n) * K + k0 + 8 * c) = o; }
    LDS_WAIT(); asm volatile("" ::: "memory");
}
struct P0Args { const float *x, *g1, *w_in, *w_attn_out, *w_conv_out, *w_o, *w_gate, *w_up, *w_down, *g2; bf16 *Win, *Wa, *Wc, *Wo, *Wgu, *Wd, *H; };
__device__ __forceinline__ void p0_prologue(const P0Args& a, LAS unsigned char* lds, int gw, int NGW, int wave, int lane) {
    LAS float* scr = (LAS float*)(lds + RING_OFF + wave * 16384);
    constexpr int I_IN = (D / 64) * (INW / 32), I_A = (512 / 64) * (D / 32), I_C = (CW / 64) * (D / 32), I_O = (D / 64) * (D / 32), I_GU = (D / 64) * (2 * FF / 32), I_D = (FF / 64) * (D / 32);
    constexpr int NITEMS = I_IN + I_A + I_C + I_O + I_GU + I_D;
    for (int it = gw; it < NITEMS; it += NGW) {
        int r = it;
        if (r < I_IN) { const int nblk = INW / 32, kb = r / nblk, nb = r % nblk, n = 32 * nb; int sn = n;
            if (n >= 3 * AW && n < 3 * AW + 2 * CW) { const int uu = n - 3 * AW, i = uu >> 8, j = uu & 255; sn = 3 * AW + (j < 128 ? 128 * i + j : CW + 128 * i + (j - 128)); }
            p0_transpose_item(a.w_in, D, INW, sn, a.Win, n, 64 * kb, nullptr, scr, lane); continue; } r -= I_IN;
        if (r < I_A) { const int nblk = D / 32, kb = r / nblk, nb = r % nblk; p0_transpose_item(a.w_attn_out, 512, D, 32 * nb, a.Wa, 32 * nb, 64 * kb, nullptr, scr, lane); continue; } r -= I_A;
        if (r < I_C) { const int nblk = D / 32, kb = r / nblk, nb = r % nblk; p0_transpose_item(a.w_conv_out, CW, D, 32 * nb, a.Wc, 32 * nb, 64 * kb, nullptr, scr, lane); continue; } r -= I_C;
        if (r < I_O) { const int nblk = D / 32, kb = r / nblk, nb = r % nblk; p0_transpose_item(a.w_o, D, D, 32 * nb, a.Wo, 32 * nb, 64 * kb, nullptr, scr, lane); continue; } r -= I_O;
        if (r < I_GU) { const int nblk = 2 * FF / 32, kb = r / nblk, nb = r % nblk, n = 32 * nb, i = n >> 8, j = n & 255;
            p0_transpose_item(j < 128 ? a.w_gate : a.w_up, D, FF, 128 * i + (j & 127), a.Wgu, n, 64 * kb, a.g2, scr, lane); continue; } r -= I_GU;
        { const int nblk = D / 32, kb = r / nblk, nb = r % nblk; p0_transpose_item(a.w_down, FF, D, 32 * nb, a.Wd, 32 * nb, 64 * kb, nullptr, scr, lane); }
    }
    for (int m = gw; m < M; m += NGW) {
        const GAS f32x4* xr = (const GAS f32x4*)(a.x + (size_t)m * D) + lane;
        f32x4 v[4]; float s = 0.f;
#pragma unroll
        for (int j = 0; j < 4; ++j) { v[j] = xr[64 * j]; s += (v[j].x * v[j].x + v[j].y * v[j].y) + (v[j].z * v[j].z + v[j].w * v[j].w); }
        const float rr = 1.f / sqrtf(wave_sum(s) * (1.f / D) + RMS_EPS);
        GAS v2u* o = (GAS v2u*)(a.H + (size_t)m * D) + lane;
#pragma unroll
        for (int j = 0; j < 4; ++j) { const f32x4 gg = ((const GAS f32x4*)a.g1)[lane + 64 * j]; v2u w; w.x = pk2(v[j].x * rr * gg.x, v[j].y * rr * gg.y); w.y = pk2(v[j].z * rr * gg.z, v[j].w * rr * gg.w); o[64 * j] = w; }
    }
}

namespace att {
typedef LAS const char* lds_cptr;
typedef short v4i16_t __attribute__((ext_vector_type(4)));
constexpr int NU = BATCH * 3 * 8 * 16;
__device__ __forceinline__ int crow(int r, int hi) { return (r & 3) + 8 * (r >> 2) + 4 * hi; }
__device__ __forceinline__ void glds16(const void* gsrc, unsigned lds_dst) { unsigned keep;
    asm volatile("s_mov_b32 %0, m0\n\ts_mov_b32 m0, %2\n\ts_nop 0\n\tglobal_load_lds_dwordx4 %1, off\n\ts_mov_b32 m0, %0" : "=&s"(keep) : "v"(gsrc), "s"(lds_dst) : "memory"); }
__device__ __forceinline__ s16x4 vtr(lds_cptr p) { return __builtin_bit_cast(s16x4, __builtin_amdgcn_ds_read_tr16_b64_v4i16((LAS v4i16_t*)p)); }
typedef __bf16 bf16x2_t __attribute__((ext_vector_type(2)));
__device__ __forceinline__ unsigned cvtpk_s(float lo, float hi) { f32x2 v = {lo, hi}; bf16x2_t b = __builtin_convertvector(v, bf16x2_t); return __builtin_bit_cast(unsigned, b); }

__device__ __forceinline__ void attn_step(int u, bf16* Q, const bf16* __restrict__ K, const bf16* __restrict__ V, float* LSE, LAS unsigned char* ring, LAS unsigned char* ost, int wid, int lane) {
    const int hw = wid & 3, half = wid >> 2, r32 = lane & 31, hi = lane >> 5;
    const bool valid = u < NU;
    const int uu = valid ? u : 0;
    const int g = uu >> 11, v = uu & 2047, b = v >> 7, hh = (v >> 4) & 7, cc = v & 15;
    const int r = 1 << (2 * g), lg = 4 - 2 * g;
    const int c = cc >> lg, qc = cc & ((1 << lg) - 1);
    const int i0 = qc * 128, tok0 = b * SEQ + c, colbase = g * 512 + hh * 64;
    const bool first = (i0 == 0);
    const float ex = g == 0 ? -0.25f * (hh + 1) : (g == 1 ? -2.f - 0.25f * (hh + 1) : -4.f - 0.5f * (hh + 1));
    const float sl2 = __builtin_amdgcn_exp2f(ex) * (float)r * LOG2E;
    const unsigned hb = (unsigned)(size_t)ring + (unsigned)half * 65536u;
    const int i0w = i0 + 32 * hw;
    bf16x8 qr[4];
    if (valid) {
#pragma unroll
        for (int tl = 0; tl < 4; ++tl) {
            if (first && tl < 2) continue;
#pragma unroll
            for (int pp = 0; pp < 2; ++pp) { const int p = hw + 4 * pp;
                const int jk = i0 - 128 + 64 * tl + lane;
                glds16(K + (size_t)(tok0 + r * jk) * AW + colbase + p * 8, (unsigned)__builtin_amdgcn_readfirstlane(hb + tl * 8192 + p * 1024));
                const int jv = i0 - 128 + 64 * tl + 16 * (p & 3) + (lane >> 2);
                glds16(V + (size_t)(tok0 + r * jv) * AW + colbase + (p >> 2) * 32 + (lane & 3) * 8, (unsigned)__builtin_amdgcn_readfirstlane(hb + 32768 + tl * 8192 + p * 1024)); }
        }
        const bf16* qp = Q + (size_t)(tok0 + r * (i0w + r32)) * AW + colbase + hi * 8;
#pragma unroll
        for (int d0 = 0; d0 < 4; ++d0) qr[d0] = *(const bf16x8*)(qp + d0 * 16);
    }
    asm volatile("s_waitcnt vmcnt(0)\n\ts_barrier" ::: "memory");
    if (valid) {
        const lds_cptr kimg = (lds_cptr)(ring + half * 65536), vimg = kimg + 32768;
        f32x16 p[5];
#pragma unroll
        for (int blk = 0; blk < 5; ++blk) {
            const int kl0 = 32 * hw + 32 * blk;
            if (first && kl0 < 128) {
#pragma unroll
                for (int rr = 0; rr < 16; ++rr) p[blk][rr] = -INFINITY;
                continue; }
#pragma unroll
            for (int rr = 0; rr < 16; ++rr) p[blk][rr] = -sl2 * (float)(128 + r32 - 32 * blk - crow(rr, hi));
            const lds_cptr kb = kimg + (kl0 >> 6) * 8192 + hi * 1024 + ((kl0 >> 5) & 1) * 512 + r32 * 16;
#pragma unroll
            for (int d0 = 0; d0 < 4; ++d0) { const bf16x8 kf = *(const LAS bf16x8*)(kb + d0 * 2048); p[blk] = __builtin_amdgcn_mfma_f32_32x32x16_bf16(kf, qr[d0], p[blk], 0, 0, 0); }
            if (blk == 0) {
#pragma unroll
                for (int rr = 0; rr < 16; ++rr) if (crow(rr, hi) < r32) p[blk][rr] = -INFINITY; }
            if (blk == 4) {
#pragma unroll
                for (int rr = 0; rr < 16; ++rr) if (crow(rr, hi) > r32) p[blk][rr] = -INFINITY; }
        }
        float mx = p[4][0];
#pragma unroll
        for (int blk = 0; blk < 5; ++blk)
#pragma unroll
            for (int rr = 0; rr < 16; ++rr) mx = __builtin_fmaxf(mx, p[blk][rr]);
        { auto sw = __builtin_amdgcn_permlane32_swap(__float_as_uint(mx), __float_as_uint(mx), false, false); mx = __builtin_fmaxf(__uint_as_float(sw[0]), __uint_as_float(sw[1])); }
        float l = 0.f;
#pragma unroll
        for (int blk = 0; blk < 5; ++blk)
#pragma unroll
            for (int rr = 0; rr < 16; ++rr) { p[blk][rr] = __builtin_amdgcn_exp2f(p[blk][rr] - mx); l += p[blk][rr]; }
        { auto sw = __builtin_amdgcn_permlane32_swap(__float_as_uint(l), __float_as_uint(l), false, false); l = __uint_as_float(sw[0]) + __uint_as_float(sw[1]); }
        f32x16 o[2]; o[0] = f32x16{}; o[1] = f32x16{};
        const int voff = ((lane >> 4) & 1) * 32 + (lane & 3) * 8 + (4 * hi + ((lane & 15) >> 2)) * 64;
#pragma unroll
        for (int blk = 0; blk < 5; ++blk) {
            const int kl0 = 32 * hw + 32 * blk;
            if (first && kl0 < 128) continue;
            v4u pw[2];
#pragma unroll
            for (int s = 0; s < 2; ++s) pw[s] = (v4u){cvtpk_s(p[blk][8 * s + 0], p[blk][8 * s + 1]), cvtpk_s(p[blk][8 * s + 2], p[blk][8 * s + 3]), cvtpk_s(p[blk][8 * s + 4], p[blk][8 * s + 5]), cvtpk_s(p[blk][8 * s + 6], p[blk][8 * s + 7])};
            const lds_cptr vb = vimg + (kl0 >> 6) * 8192 + ((kl0 >> 5) & 1) * 2048 + voff;
#pragma unroll
            for (int dh = 0; dh < 2; ++dh)
#pragma unroll
                for (int s = 0; s < 2; ++s) { const s16x4 lo = vtr(vb + dh * 4096 + s * 1024), hi4 = vtr(vb + dh * 4096 + s * 1024 + 512);
                    const bf16x8 vf = (bf16x8){lo[0], lo[1], lo[2], lo[3], hi4[0], hi4[1], hi4[2], hi4[3]};
                    o[dh] = __builtin_amdgcn_mfma_f32_32x32x16_bf16(__builtin_bit_cast(bf16x8, pw[s]), vf, o[dh], 0, 0, 0); }
        }
        LAS float* wsf = (LAS float*)(ost + wid * OSTW); LAS bf16* stg = (LAS bf16*)(wsf + 32);
        if (hi == 0) { wsf[r32] = __builtin_amdgcn_rcpf(l); LSE[(size_t)(tok0 + r * (i0w + r32)) * NH + g * 8 + hh] = mx + __builtin_amdgcn_logf(l); }
        LDS_WAIT();
        float rli[16];
#pragma unroll
        for (int rr = 0; rr < 16; ++rr) rli[rr] = wsf[crow(rr, hi)];
#pragma unroll
        for (int ps = 0; ps < 2; ++ps) {
#pragma unroll
            for (int rr = 8 * ps; rr < 8 * ps + 8; ++rr) { const int orow = crow(rr, hi) - 16 * ps;
#pragma unroll
                for (int dh = 0; dh < 2; ++dh) stg[orow * 64 + dh * 32 + r32] = (bf16)f2bf(o[dh][rr] * rli[rr]); }
            LDS_WAIT();
#pragma unroll
            for (int i = 0; i < 2; ++i) { const int row = i * 8 + (lane >> 3), ch = lane & 7; const v4u vv = *(const LAS v4u*)(stg + row * 64 + ch * 8);
                *(v4u*)(Q + (size_t)(tok0 + r * (i0w + 16 * ps + row)) * AW + colbase + ch * 8) = vv; }
            LDS_WAIT();
        }
    }
    asm volatile("s_waitcnt lgkmcnt(0)\n\ts_barrier" ::: "memory");
}
}

namespace cv {
constexpr int R = 32, NUNIT = M / R;
__device__ __forceinline__ void conv_unit(int cu, const bf16* __restrict__ C, const float* __restrict__ w, const float* __restrict__ cb, const float* __restrict__ lg, const float* __restrict__ lb,
                                          bf16* C2o, LAS unsigned char* lds, int tid, int wid, int lane) {
    const int row0 = cu * R, ch = tid * 2;
    const bool firstc = (row0 % SEQ) == 0;
    f32x2 wk[KCONV];
#pragma unroll
    for (int k = 0; k < KCONV; ++k) wk[k] = *(const f32x2*)(w + (size_t)k * CW + ch);
    const f32x2 bias = *(const f32x2*)(cb + ch);
    f32x2 y[R];
#pragma unroll
    for (int o = 0; o < R; ++o) y[o] = bias;
    const bf16* xbase = C + ((long)row0 - (KCONV - 1)) * CW + ch;
#pragma unroll
    for (int c0 = 0; c0 < R + KCONV - 1; c0 += 16) {
        unsigned xs[16];
#pragma unroll
        for (int ii = 0; ii < 16; ++ii) { const int i = c0 + ii; if (i < R + KCONV - 1) { xs[ii] = *(const unsigned*)(xbase + (size_t)i * CW); if (i < KCONV - 1 && firstc) xs[ii] = 0u; } }
#pragma unroll
        for (int ii = 0; ii < 16; ++ii) { const int i = c0 + ii; if (i < R + KCONV - 1) { const f32x2 xv = {bflo(xs[ii]), bfhi(xs[ii])};
#pragma unroll
            for (int o = 0; o < R; ++o) { const int k = i - o; if (k >= 0 && k < KCONV) y[o] += wk[k] * xv; } } }
        asm volatile("" ::: "memory");
    }
    float v[32];
#pragma unroll
    for (int j = 0; j < 32; ++j) { const float a = y[j].x + y[j].y, b = y[j].x * y[j].x + y[j].y * y[j].y;
        auto sw = __builtin_amdgcn_permlane32_swap(__float_as_uint(a), __float_as_uint(b), false, false); v[j] = __uint_as_float(sw[0]) + __uint_as_float(sw[1]); }
#define CV_RED(W2, BIT) { const bool up = (lane >> BIT) & 1; _Pragma("unroll") for (int j = 0; j < W2; ++j) { const float send = up ? v[j] : v[j + W2], keep = up ? v[j + W2] : v[j]; v[j] = keep + __shfl_xor(send, W2); } }
    CV_RED(16, 4) CV_RED(8, 3) CV_RED(4, 2) CV_RED(2, 1) CV_RED(1, 0)
#undef CV_RED
    LAS float* red = (LAS float*)(lds + RING_OFF);
    LAS f32x2* st = (LAS f32x2*)(lds + RING_OFF + 2048);
    red[wid * 64 + lane] = v[0];
    LDS_WAIT(); __builtin_amdgcn_s_barrier(); asm volatile("" ::: "memory");
    if (tid < 32) { float s1 = 0.f, s2 = 0.f;
#pragma unroll
        for (int ww = 0; ww < 8; ++ww) { s1 += red[ww * 64 + tid]; s2 += red[ww * 64 + 32 + tid]; }
        const float mean = s1 * (1.f / CW), var = s2 * (1.f / CW) - mean * mean; st[tid] = (f32x2){mean, 1.f / sqrtf(var + LN_EPS)}; }
    LDS_WAIT(); __builtin_amdgcn_s_barrier(); asm volatile("" ::: "memory");
    const f32x2 gg = *(const f32x2*)(lg + ch), bb = *(const f32x2*)(lb + ch);
#pragma unroll
    for (int o = 0; o < R; ++o) { const f32x2 ms = st[o]; const float a = (y[o].x - ms.x) * ms.y * gg.x + bb.x, b2 = (y[o].y - ms.x) * ms.y * gg.y + bb.y;
        *(unsigned*)(C2o + (size_t)(row0 + o) * CW + ch) = pk2(a * sigm_fast(a), b2 * sigm_fast(b2)); }
    LDS_WAIT(); __builtin_amdgcn_s_barrier(); asm volatile("" ::: "memory");
}
}

__device__ __forceinline__ void combine_row(int row, const bf16* O, const float* LSE, bf16* ATT, int lane) {
    const int hh = lane >> 3;
    const float l0 = LSE[(size_t)row * NH + hh], l1 = LSE[(size_t)row * NH + 8 + hh], l2 = LSE[(size_t)row * NH + 16 + hh];
    const float mx = fmaxf(l0, fmaxf(l1, l2));
    float a0 = __builtin_amdgcn_exp2f(l0 - mx), a1 = __builtin_amdgcn_exp2f(l1 - mx), a2 = __builtin_amdgcn_exp2f(l2 - mx); const float inv = 1.f / (a0 + a1 + a2); a0 *= inv; a1 *= inv; a2 *= inv;
    const v4u v0 = *(const v4u*)(O + (size_t)row * AW + lane * 8), v1 = *(const v4u*)(O + (size_t)row * AW + 512 + lane * 8), v2 = *(const v4u*)(O + (size_t)row * AW + 1024 + lane * 8);
    v4u o;
#pragma unroll
    for (int j = 0; j < 4; ++j) o[j] = pk2(a0 * bflo(v0[j]) + a1 * bflo(v1[j]) + a2 * bflo(v2[j]), a0 * bfhi(v0[j]) + a1 * bfhi(v1[j]) + a2 * bfhi(v2[j]));
    *(v4u*)(ATT + (size_t)row * 512 + lane * 8) = o;
}
__device__ __forceinline__ void final_row(int row, float* x, const float* ss, const float* g, int lane) {
    const f32x4* sp = (const f32x4*)(ss + (size_t)row * 16); const f32x4 s4 = (sp[0] + sp[1]) + (sp[2] + sp[3]);
    const float r = 1.f / sqrtf(((s4[0] + s4[1]) + (s4[2] + s4[3])) * (1.f / D) + RMS_EPS);
    f32x4* xr = (f32x4*)(x + (size_t)row * D) + lane;
#pragma unroll
    for (int j = 0; j < 4; ++j) { f32x4 v = xr[64 * j]; const f32x4 gg = ((const f32x4*)g)[lane + 64 * j]; v = v * gg * r; xr[64 * j] = v; }
}

#define XB_TMO      128
#define XB_XCNT(j)  (256  + 64 * (j))
#define XB_XSUB(j)  (1280 + 64 * (j))
#define XB_XGEN(j)  (2304 + 64 * (j))
#define XB_TOP      3328
#define XB_TOPGEN   3392
#define XCD_BAR_WORDS 3456
#define XB_SPIN_CAP (1u << 18)

__device__ __forceinline__ unsigned xb_ld(unsigned* p)              { return __hip_atomic_load(p, __ATOMIC_RELAXED, __HIP_MEMORY_SCOPE_AGENT); }
__device__ __forceinline__ unsigned xb_add(unsigned* p, unsigned v) { return __hip_atomic_fetch_add(p, v, __ATOMIC_RELAXED, __HIP_MEMORY_SCOPE_AGENT); }
__device__ __forceinline__ unsigned xb_xcc_id() { return (unsigned)__builtin_amdgcn_s_getreg((3 << 11) | 20) & 0xFu; }
#define XB_SPIN(cond, bar) do { unsigned _sp = 0; while (cond) { __builtin_amdgcn_s_sleep(1); \
    if ((++_sp & 255u) == 0u) { if (xb_ld(&(bar)[XB_TMO])) break; if (_sp > XB_SPIN_CAP) { atomicAdd(&(bar)[XB_TMO], 1u); break; } } } } while (0)

struct XcdBarrier {
    unsigned* bar; unsigned x;
    volatile LAS unsigned* st;
};

__device__ __forceinline__ XcdBarrier xcd_barrier_post(unsigned* bar, volatile LAS unsigned* st) {
    XcdBarrier b; b.bar = bar; b.x = xb_xcc_id(); b.st = st;
    if (threadIdx.x == 0) (void)xb_add(&bar[XB_XCNT(b.x)], 1u);
    return b;
}
__device__ __forceinline__ void xcd_barrier_complete(unsigned* bar, unsigned x, unsigned& nloc, unsigned& nx) {
    const unsigned G = gridDim.x * gridDim.y * gridDim.z;
    unsigned sum, cnt, mine, sp = 0u;
    for (;;) {
        sum = 0u; cnt = 0u; mine = 0u;
#pragma unroll
        for (unsigned j = 0; j < 16; ++j) { const unsigned c = xb_ld(&bar[XB_XCNT(j)]); sum += c; cnt += (c > 0u) ? 1u : 0u; mine = (j == x) ? c : mine; }
        if (sum == G) break;
        __builtin_amdgcn_s_sleep(1);
        if ((++sp & 255u) == 0u) { if (xb_ld(&bar[XB_TMO])) break; if (sp > XB_SPIN_CAP) { atomicAdd(&bar[XB_TMO], 1u); break; } }
    }
    nloc = mine > 0u ? mine : 1u; nx = cnt > 0u ? cnt : 1u;
}

__device__ __forceinline__ void xcd_barrier(const XcdBarrier& b) {
    asm volatile("s_waitcnt vmcnt(0)" ::: "memory");
    __syncthreads();
    if (threadIdx.x == 0) {
        unsigned* bar = b.bar;
        __builtin_amdgcn_s_waitcnt(0);
        unsigned nloc = b.st[0], nx = b.st[1];
        if (nloc == 0u) { xcd_barrier_complete(bar, b.x, nloc, nx); b.st[0] = nloc; b.st[1] = nx; }
        const unsigned old = xb_add(&bar[XB_XSUB(b.x)], 1u);
        const unsigned gen = old / nloc;
        if (old + 1u == (gen + 1u) * nloc) {
            __builtin_amdgcn_fence(__ATOMIC_RELEASE, "agent");
            asm volatile("s_waitcnt vmcnt(0)" ::: "memory");
            const unsigned og = xb_add(&bar[XB_TOP], 1u);
            const unsigned tg = og / nx;
            if (og + 1u == (tg + 1u) * nx) xb_add(&bar[XB_TOPGEN], 1u);
            else XB_SPIN(xb_ld(&bar[XB_TOPGEN]) == tg, bar);
            __builtin_amdgcn_fence(__ATOMIC_ACQUIRE, "agent");
            xb_add(&bar[XB_XGEN(b.x)], 1u);
            asm volatile("s_waitcnt vmcnt(0)" ::: "memory");
        } else {
            XB_SPIN(xb_ld(&bar[XB_XGEN(b.x)]) == gen, bar);
            __builtin_amdgcn_fence(__ATOMIC_ACQUIRE, "agent");
            asm volatile("s_waitcnt vmcnt(0)" ::: "memory");
        }
    }
    __syncthreads();
}
constexpr int NWAVES = 8;
constexpr int CW_BAR = 4096;
constexpr int NPHASE = 9;
struct Args { const float* in[16]; float* out; unsigned char* ws; int ph_lo, ph_hi, li, pad; };
static_assert(sizeof(Args) == 16 * 8 + 8 + 8 + 16, "no padding bytes in the kernel argument");

__global__ void __launch_bounds__(NWAVES * 64, 2) mk_fwd(Args args) {
    extern __shared__ __attribute__((aligned(16))) unsigned char lds[];
    LAS unsigned char* L = (LAS unsigned char*)lds;
    volatile LAS unsigned* MISC = (volatile LAS unsigned*)(L + MISC_OFF);
    const int tid = threadIdx.x, lane = tid & 63, wave = __builtin_amdgcn_readfirstlane(tid >> 6);
    const int G = gridDim.x; const int bx = blockIdx.x; const int vcu = (G % 8 == 0) ? (bx % 8) * (G / 8) + bx / 8 : bx;
    unsigned char* ws = args.ws;
    gu32* ctl = (gu32*)(ws + WS_CTL);
    const float* x = args.in[0]; float* out = args.out;
    bf16 *Win = (bf16*)(ws + WS_WIN), *Wa = (bf16*)(ws + WS_WA), *Wc = (bf16*)(ws + WS_WC), *Wo = (bf16*)(ws + WS_WO), *Wgu = (bf16*)(ws + WS_WGU), *Wd = (bf16*)(ws + WS_WD);
    bf16 *Qb = (bf16*)(ws + WS_Q), *Kb = (bf16*)(ws + WS_K), *Vb = (bf16*)(ws + WS_V), *Hb = (bf16*)(ws + WS_H), *Cb = (bf16*)(ws + WS_C);
    bf16 *ATT = (bf16*)(ws + WS_ATT), *ZA = (bf16*)(ws + WS_ZA), *HID = (bf16*)(ws + WS_HID), *C2b = (bf16*)(ws + WS_C2), *X1B = (bf16*)(ws + WS_X1B), *Zb = (bf16*)(ws + WS_Z);
    float *SS1 = (float*)(ws + WS_SS1), *SS2 = (float*)(ws + WS_SS2), *LSE = (float*)(ws + WS_LSE);
    bf16* Gates = (bf16*)out;
    for (int u = tid; u < (LDS_BYTES - LDSCTL_OFF) / 4; u += NWAVES * 64) ((LAS unsigned*)(L + LDSCTL_OFF))[u] = 0u;
    __syncthreads();
    const int lo = args.ph_lo, hi = args.ph_hi;
    XcdBarrier bar; bar.bar = (unsigned*)(ctl + CW_BAR) + args.li * XCD_BAR_WORDS; bar.x = 0; bar.st = nullptr;
    if (hi - lo > 1) bar = xcd_barrier_post((unsigned*)(ctl + CW_BAR) + args.li * XCD_BAR_WORDS, MISC + 8);
#ifndef PHMASK
#define PHMASK 0x1ff
#endif
#define IN(k) (((PHMASK >> (k)) & 1) && lo <= (k) && (k) < hi)
#define SEAM(k) do { if (IN(k) && IN((k) + 1)) xcd_barrier(bar); } while (0)
    const int gw = vcu * NWAVES + wave, NGW = G * NWAVES;

    if (IN(0)) {
        P0Args a{x, args.in[1], args.in[2], args.in[9], args.in[8], args.in[10], args.in[12], args.in[13], args.in[14], args.in[11], Win, Wa, Wc, Wo, Wgu, Wd, Hb};
        p0_prologue(a, L, gw, NGW, wave, lane);
    }
    SEAM(0);
    if (IN(1)) {
        pg8::Gemm g{Hb, Win, M, INW, D}; pg8::StaticOrder S; S.init(M, INW, G, bx);
        pg8::EpiIn E{Qb, Cb, Gates, args.in[3], (size_t)(WS_K - WS_Q) / 2};
        pg8::gemm_phase<pg8::EpiIn, pg8::StaticOrder, true, true>(L + RING_OFF, g, S, E);
    }
    SEAM(1);
    if (IN(2)) {
#ifndef NO_ATTN
        for (int s = 0; s * 2 * G < att::NU; ++s) att::attn_step(s * 2 * G + vcu * 2 + (wave >> 2), Qb, Kb, Vb, LSE, L + RING_OFF, L + OST_OFF, wave, lane);
#endif
#ifndef NO_CONV
        for (int cu = vcu; cu < cv::NUNIT; cu += G) cv::conv_unit(cu, Cb, args.in[4], args.in[5], args.in[6], args.in[7], C2b, L, tid, wave, lane);
#endif
    }
    SEAM(2);
    if (IN(3)) { for (int m = gw; m < M; m += NGW) combine_row(m, Qb, LSE, ATT, lane); }
    SEAM(3);
    if (IN(4)) {
        { pg8::Gemm g{ATT, Wa, M, D, 512}; pg8::StaticOrder S; S.init(M, D, G, bx); pg8::EpiMerge<0> E{Gates, nullptr, ZA};
          pg8::gemm_phase<pg8::EpiMerge<0>, pg8::StaticOrder, true, true>(L + RING_OFF, g, S, E); }
        { pg8::Gemm g{C2b, Wc, M, D, CW}; pg8::StaticOrder S; S.init(M, D, G, bx); pg8::EpiMerge<1> E{Gates, ZA, Zb};
          pg8::gemm_phase<pg8::EpiMerge<1>, pg8::StaticOrder, true, true>(L + RING_OFF, g, S, E); }
    }
    SEAM(4);
    if (IN(5)) {
        pg8::Gemm g{Zb, Wo, M, D, D}; pg8::StaticOrder S; S.init(M, D, G, bx); pg8::EpiRes<true> E{x, out, X1B, SS1};
        pg8::gemm_phase<pg8::EpiRes<true>, pg8::StaticOrder, true, true>(L + RING_OFF, g, S, E);
    }
    SEAM(5);
    if (IN(6)) {
        pg8::Gemm g{X1B, Wgu, M, 2 * FF, D}; pg8::StaticOrder S; S.init(M, 2 * FF, G, bx); pg8::EpiHid E{SS1, HID};
        pg8::gemm_phase<pg8::EpiHid, pg8::StaticOrder, true, true>(L + RING_OFF, g, S, E);
    }
    SEAM(6);
    if (IN(7)) {
        pg8::Gemm g{HID, Wd, M, D, FF}; pg8::StaticOrder S; S.init(M, D, G, bx); pg8::EpiRes<false> E{out, out, nullptr, SS2};
        pg8::gemm_phase<pg8::EpiRes<false>, pg8::StaticOrder, true, true>(L + RING_OFF, g, S, E);
    }
    SEAM(7);
    if (IN(8)) { for (int m = gw; m < M; m += NGW) final_row(m, out, SS2, args.in[15], lane); }
#undef IN
#undef SEAM
}

typedef unsigned short bf16_t;
typedef unsigned u32x4 __attribute__((ext_vector_type(4)));
typedef unsigned u32x2 __attribute__((ext_vector_type(2)));
__global__ void k_prep_w(const float* W, const float* W2, int K, int Nsrc, int Ndst, int mode, const float* ks, bf16_t* WT) {
    const size_t idx = (size_t)blockIdx.x * 256 + threadIdx.x;
    if (idx >= (size_t)Ndst * K) return;
    const int n = (int)(idx % Ndst), k = (int)(idx / Ndst);
    const float* src = W; int sn = n;
    if (mode == 1) {
        if (n >= 3 * AW && n < 3 * AW + 2 * CW) { const int u = n - 3 * AW, i = u >> 8, j = u & 255; sn = 3 * AW + (j < 128 ? 128 * i + j : CW + 128 * i + (j - 128)); }
    } else if (mode == 2) {
        const int i = n >> 8, j = n & 255; if (j < 128) sn = 128 * i + j; else { sn = 128 * i + (j - 128); src = W2; }
    }
    float v = src[(size_t)k * Nsrc + sn];
    if (ks) v *= ks[k];
    WT[(size_t)n * K + k] = (bf16_t)f2bf(v);
}

__global__ void k_rmsnorm_bf16(const float* x, const float* g, bf16_t* out) {
    const int row = blockIdx.x * 4 + (threadIdx.x >> 6), lane = threadIdx.x & 63;
    const f32x4* xr = (const f32x4*)(x + (size_t)row * D) + lane;
    f32x4 v[4]; float s = 0.f;
#pragma unroll
    for (int j = 0; j < 4; ++j) { v[j] = xr[64 * j]; s += (v[j].x * v[j].x + v[j].y * v[j].y) + (v[j].z * v[j].z + v[j].w * v[j].w); }
    const float r = 1.f / sqrtf(wave_sum(s) * (1.f / D) + RMS_EPS);
    u32x2* o = (u32x2*)(out + (size_t)row * D) + lane;
#pragma unroll
    for (int j = 0; j < 4; ++j) { const f32x4 gg = ((const f32x4*)g)[lane + 64 * j];
        u32x2 w; w.x = f2bf(v[j].x * r * gg.x) | (f2bf(v[j].y * r * gg.y) << 16); w.y = f2bf(v[j].z * r * gg.z) | (f2bf(v[j].w * r * gg.w) << 16); o[64 * j] = w; }
}

template <class Epi, bool DUAL>
__global__ __launch_bounds__(256) void k_gemm(const bf16_t* A, const bf16_t* Bt, int K, int boff, int pair, Epi e) {
    __shared__ __attribute__((aligned(16))) bf16_t sA[64][40];
    __shared__ __attribute__((aligned(16))) bf16_t sB[64][40];
    __shared__ __attribute__((aligned(16))) bf16_t sB2[64][40];
    const int tid = threadIdx.x, w = tid >> 6, lane = tid & 63;
    const int row0 = blockIdx.y * 64, col0 = blockIdx.x * 64;
    const int lr = tid >> 2, lc = (tid & 3) * 8;
    const int bc = col0 + lr, br = boff + (pair ? 256 * (bc >> 7) + (bc & 127) : bc);
    const bf16_t* ap = A + (size_t)(row0 + lr) * K + lc;
    const bf16_t* bp = Bt + (size_t)br * K + lc;
    const bf16_t* bp2 = bp + (size_t)128 * K;
    f32x4 acc[4], acc2[4];
#pragma unroll
    for (int n = 0; n < 4; ++n) { acc[n] = (f32x4){0.f, 0.f, 0.f, 0.f}; acc2[n] = (f32x4){0.f, 0.f, 0.f, 0.f}; }
    for (int k0 = 0; k0 < K; k0 += 32) {
        *(u32x4*)&sA[lr][lc] = *(const u32x4*)(ap + k0);
        *(u32x4*)&sB[lr][lc] = *(const u32x4*)(bp + k0);
        if (DUAL) *(u32x4*)&sB2[lr][lc] = *(const u32x4*)(bp2 + k0);
        __syncthreads();
        const bf16x8 a = *(const bf16x8*)&sA[w * 16 + (lane & 15)][(lane >> 4) * 8];
#pragma unroll
        for (int n = 0; n < 4; ++n) {
            const bf16x8 b = *(const bf16x8*)&sB[n * 16 + (lane & 15)][(lane >> 4) * 8];
            acc[n] = __builtin_amdgcn_mfma_f32_16x16x32_bf16(a, b, acc[n], 0, 0, 0);
            if (DUAL) { const bf16x8 b2 = *(const bf16x8*)&sB2[n * 16 + (lane & 15)][(lane >> 4) * 8];
                acc2[n] = __builtin_amdgcn_mfma_f32_16x16x32_bf16(a, b2, acc2[n], 0, 0, 0); }
        }
        __syncthreads();
    }
#pragma unroll
    for (int n = 0; n < 4; ++n)
#pragma unroll
        for (int j = 0; j < 4; ++j) e(row0 + w * 16 + (lane >> 4) * 4 + j, col0 + n * 16 + (lane & 15), acc[n][j], acc2[n][j]);
}

struct EpQKV { bf16_t* q;
    __device__ void operator()(int row, int col, float a, float) const { const int t = col / AW, c = col - t * AW;
        bf16_t* o = q + (size_t)t * ((WS_K - WS_Q) / 2); o[(size_t)row * AW + c] = (bf16_t)f2bf(t == 0 ? a * C2 : a); } };
struct EpGLU { bf16_t* c;
    __device__ void operator()(int row, int col, float a, float b) const { c[(size_t)row * CW + col] = (bf16_t)f2bf(a * sigmoidf_(b)); } };
struct EpGate { bf16_t* g; const float* gb;
    __device__ void operator()(int row, int col, float a, float) const { g[(size_t)row * 2048 + col] = (bf16_t)f2bf(sigmoidf_(a + gb[col])); } };
struct EpZA { const bf16_t* g; bf16_t* za;
    __device__ void operator()(int row, int col, float a, float) const { za[(size_t)row * D + col] = (bf16_t)f2bf(bf2f(g[(size_t)row * 2048 + col]) * a); } };
struct EpZ { const bf16_t* g; const bf16_t* za; bf16_t* z;
    __device__ void operator()(int row, int col, float a, float) const { z[(size_t)row * D + col] = (bf16_t)f2bf(bf2f(za[(size_t)row * D + col]) + bf2f(g[(size_t)row * 2048 + 1024 + col]) * a); } };
struct EpX1 { const float* x; float* x1; bf16_t* x1b;
    __device__ void operator()(int row, int col, float a, float) const { const float v = x[(size_t)row * D + col] + a; x1[(size_t)row * D + col] = v; x1b[(size_t)row * D + col] = (bf16_t)f2bf(v); } };
struct EpHid { const float* ss1; bf16_t* hid;
    __device__ void operator()(int row, int col, float a, float b) const { float s = 0.f;
#pragma unroll
        for (int i = 0; i < 16; ++i) s += ss1[(size_t)row * 16 + i];
        const float r = 1.f / sqrtf(s * (1.f / D) + RMS_EPS); const float gv = a * r, uv = b * r;
        hid[(size_t)row * FF + col] = (bf16_t)f2bf(gv * sigmoidf_(gv) * uv); } };
struct EpX2 { float* x;
    __device__ void operator()(int row, int col, float a, float) const { x[(size_t)row * D + col] += a; } };

__global__ void k_rowss(const float* x, float* ss) {
    const int row = blockIdx.x * 4 + (threadIdx.x >> 6), lane = threadIdx.x & 63;
    const f32x4* xr = (const f32x4*)(x + (size_t)row * D) + lane; float s = 0.f;
#pragma unroll
    for (int j = 0; j < 4; ++j) { const f32x4 v = xr[64 * j]; s += (v.x * v.x + v.y * v.y) + (v.z * v.z + v.w * v.w); }
    s = wave_sum(s);
    if (lane < 16) ss[(size_t)row * 16 + lane] = lane == 0 ? s : 0.f;
}
__global__ void k_final(float* x, const float* ss, const float* g) {
    const int row = blockIdx.x * 4 + (threadIdx.x >> 6), lane = threadIdx.x & 63;
    float s = 0.f;
#pragma unroll
    for (int i = 0; i < 16; ++i) s += ss[(size_t)row * 16 + i];
    const float r = 1.f / sqrtf(s * (1.f / D) + RMS_EPS);
    f32x4* xr = (f32x4*)(x + (size_t)row * D) + lane;
#pragma unroll
    for (int j = 0; j < 4; ++j) { f32x4 v = xr[64 * j]; const f32x4 gg = ((const f32x4*)g)[lane + 64 * j]; v.x *= r * gg.x; v.y *= r * gg.y; v.z *= r * gg.z; v.w *= r * gg.w; xr[64 * j] = v; }
}

__global__ __launch_bounds__(256) void k_attn_naive(bf16_t* Q, const bf16_t* Kb, const bf16_t* Vb, float* LSE) {
    const int idx = blockIdx.x * 256 + threadIdx.x;
    const int h = idx % NH, row = idx / NH, g = h >> 3, hh = h & 7;
    const int r = g == 0 ? 1 : (g == 1 ? 4 : 16);
    const int t = row % SEQ, i = t / r;
    const float ex = g == 0 ? -0.25f * (hh + 1) : (g == 1 ? -2.f - 0.25f * (hh + 1) : -4.f - 0.5f * (hh + 1));
    const float sl2 = exp2f(ex) * (float)r * LOG2E;
    float q[64], acc[64];
    bf16_t* qp = Q + (size_t)row * AW + h * 64;
#pragma unroll
    for (int d = 0; d < 64; ++d) { q[d] = bf2f(qp[d]); acc[d] = 0.f; }
    float m = -INFINITY, l = 0.f;
    const int nd = i < 128 ? i : 128;
    for (int dd = 0; dd <= nd; ++dd) {
        const size_t krow = (size_t)(row - r * dd);
        const bf16_t* kp = Kb + krow * AW + h * 64; const bf16_t* vp = Vb + krow * AW + h * 64;
        float s = 0.f;
#pragma unroll
        for (int d = 0; d < 64; ++d) s += q[d] * bf2f(kp[d]);
        s -= sl2 * (float)dd;
        if (s > m) { const float f = exp2f(m - s); l *= f;
#pragma unroll
            for (int d = 0; d < 64; ++d) acc[d] *= f;
            m = s; }
        const float p = exp2f(s - m); l += p;
#pragma unroll
        for (int d = 0; d < 64; ++d) acc[d] += p * bf2f(vp[d]);
    }
    const float il = 1.f / l;
#pragma unroll
    for (int d = 0; d < 64; ++d) qp[d] = (bf16_t)f2bf(acc[d] * il);
    LSE[(size_t)row * NH + h] = m + log2f(l);
}
__global__ void k_combine(const bf16_t* O, const float* LSE, bf16_t* ATT) {
    const int row = blockIdx.x * 4 + (threadIdx.x >> 6), lane = threadIdx.x & 63, hh = lane >> 3;
    const float l0 = LSE[(size_t)row * NH + hh], l1 = LSE[(size_t)row * NH + 8 + hh], l2 = LSE[(size_t)row * NH + 16 + hh];
    const float mx = fmaxf(l0, fmaxf(l1, l2));
    float a0 = exp2f(l0 - mx), a1 = exp2f(l1 - mx), a2 = exp2f(l2 - mx); const float inv = 1.f / (a0 + a1 + a2); a0 *= inv; a1 *= inv; a2 *= inv;
    const u32x4 v0 = *(const u32x4*)(O + (size_t)row * AW + lane * 8), v1 = *(const u32x4*)(O + (size_t)row * AW + 512 + lane * 8), v2 = *(const u32x4*)(O + (size_t)row * AW + 1024 + lane * 8);
    u32x4 o;
#pragma unroll
    for (int j = 0; j < 4; ++j) {
        const float lo = a0 * bf2f(v0[j] & 0xffffu) + a1 * bf2f(v1[j] & 0xffffu) + a2 * bf2f(v2[j] & 0xffffu);
        const float hi = a0 * bf2f(v0[j] >> 16) + a1 * bf2f(v1[j] >> 16) + a2 * bf2f(v2[j] >> 16);
        o[j] = f2bf(lo) | (f2bf(hi) << 16);
    }
    *(u32x4*)(ATT + (size_t)row * 512 + lane * 8) = o;
}
__global__ __launch_bounds__(256) void k_conv_naive(const bf16_t* C, const float* w, const float* cb, const float* lg, const float* lb, bf16_t* C2o) {
    __shared__ float red[8];
    const int row = blockIdx.x, t = row % SEQ, tid = threadIdx.x, ch = tid * 4;
    float y[4];
#pragma unroll
    for (int i = 0; i < 4; ++i) y[i] = cb[ch + i];
    for (int k = 0; k < KCONV; ++k) { const int tt = t - (KCONV - 1) + k; if (tt < 0) continue;
        const u32x2 xv = *(const u32x2*)(C + (size_t)(row - (KCONV - 1) + k) * CW + ch); const f32x4 wv = *(const f32x4*)(w + (size_t)k * CW + ch);
        y[0] += wv.x * bf2f(xv.x & 0xffffu); y[1] += wv.y * bf2f(xv.x >> 16); y[2] += wv.z * bf2f(xv.y & 0xffffu); y[3] += wv.w * bf2f(xv.y >> 16); }
    float s = wave_sum((y[0] + y[1]) + (y[2] + y[3]));
    if ((tid & 63) == 0) red[tid >> 6] = s;
    __syncthreads();
    const float mean = (red[0] + red[1] + red[2] + red[3]) * (1.f / CW);
    float q = 0.f;
#pragma unroll
    for (int i = 0; i < 4; ++i) { y[i] -= mean; q += y[i] * y[i]; }
    q = wave_sum(q);
    if ((tid & 63) == 0) red[4 + (tid >> 6)] = q;
    __syncthreads();
    const float rstd = 1.f / sqrtf((red[4] + red[5] + red[6] + red[7]) * (1.f / CW) + LN_EPS);
    float o[4];
#pragma unroll
    for (int i = 0; i < 4; ++i) { const float v = y[i] * rstd * lg[ch + i] + lb[ch + i]; o[i] = v * sigmoidf_(v); }
    u32x2 ov; ov.x = f2bf(o[0]) | (f2bf(o[1]) << 16); ov.y = f2bf(o[2]) | (f2bf(o[3]) << 16);
    *(u32x2*)(C2o + (size_t)row * CW + ch) = ov;
}


#ifndef FASTMASK
#define FASTMASK 0x1ff
#endif
#ifndef MK_SPLIT
#define MK_SPLIT 0
#endif
extern "C" void kernel_launch(void* const* d_in, const int* in_sizes, int n_in, void* d_out, int out_size, void* d_ws, size_t ws_size, hipStream_t stream) {
    static int grid = 0;
    if (grid == 0) {
        if (n_in != 16 || out_size != M * D || ws_size < WS_END) { fprintf(stderr, "kernel_launch: unexpected shapes (n_in %d out %d ws %zu)\n", n_in, out_size, ws_size); grid = -1; return; }
        int dev = 0, cus = 0, per_cu = 0;
        if (hipGetDevice(&dev) != hipSuccess || hipDeviceGetAttribute(&cus, hipDeviceAttributeMultiprocessorCount, dev) != hipSuccess) { grid = -1; return; }
        if (hipFuncSetAttribute((const void*)mk_fwd, hipFuncAttributeMaxDynamicSharedMemorySize, LDS_BYTES) != hipSuccess) { fprintf(stderr, "kernel_launch: hipFuncSetAttribute failed\n"); grid = -1; return; }
        if (hipOccupancyMaxActiveBlocksPerMultiprocessor(&per_cu, (const void*)mk_fwd, NWAVES * 64, LDS_BYTES) != hipSuccess || per_cu < 1) fprintf(stderr, "kernel_launch: occupancy query reports %d\n", per_cu);
        (void)hipGetLastError();
        grid = cus;
    }
    if (grid < 0) return;
    const float* x = (const float*)d_in[0]; const float* norm1_g = (const float*)d_in[1]; const float* w_in = (const float*)d_in[2]; const float* gate_b = (const float*)d_in[3];
    const float* conv_w = (const float*)d_in[4]; const float* conv_b = (const float*)d_in[5]; const float* ln_g = (const float*)d_in[6]; const float* ln_b = (const float*)d_in[7];
    const float* w_conv_out = (const float*)d_in[8]; const float* w_attn_out = (const float*)d_in[9]; const float* w_o = (const float*)d_in[10]; const float* norm2_g = (const float*)d_in[11];
    const float* w_gate = (const float*)d_in[12]; const float* w_up = (const float*)d_in[13]; const float* w_down = (const float*)d_in[14]; const float* norm_f_g = (const float*)d_in[15];
    unsigned char* ws = (unsigned char*)d_ws; float* out = (float*)d_out;
    bf16_t *Win = (bf16_t*)(ws + WS_WIN), *Wa = (bf16_t*)(ws + WS_WA), *Wc = (bf16_t*)(ws + WS_WC), *Wo = (bf16_t*)(ws + WS_WO), *Wgu = (bf16_t*)(ws + WS_WGU), *Wd = (bf16_t*)(ws + WS_WD);
    bf16_t *Qb = (bf16_t*)(ws + WS_Q), *Kb = (bf16_t*)(ws + WS_K), *Vb = (bf16_t*)(ws + WS_V), *Hb = (bf16_t*)(ws + WS_H), *Cb = (bf16_t*)(ws + WS_C);
    bf16_t *ATT = (bf16_t*)(ws + WS_ATT), *ZA = (bf16_t*)(ws + WS_ZA), *HID = (bf16_t*)(ws + WS_HID), *C2b = (bf16_t*)(ws + WS_C2), *X1B = (bf16_t*)(ws + WS_X1B), *Zb = (bf16_t*)(ws + WS_Z);
    float *SS1 = (float*)(ws + WS_SS1), *SS2 = (float*)(ws + WS_SS2), *LSE = (float*)(ws + WS_LSE);
    bf16_t* Gates = (bf16_t*)d_out;
    if (FASTMASK) (void)hipMemsetAsync(ws + WS_CTL, 0, CTL_ZERO_BYTES, stream);
    Args a{};
    for (int i = 0; i < 16; ++i) a.in[i] = (const float*)d_in[i];
    a.out = out; a.ws = ws;
    auto nb = [](size_t n) { return (unsigned)((n + 255) / 256); };
    int li = 0;
    for (int k = 0; k < NPHASE; ) {
        if ((FASTMASK >> k) & 1) {
            int e = k + 1; if (!MK_SPLIT) while (e < NPHASE && ((FASTMASK >> e) & 1)) ++e;
            a.ph_lo = k; a.ph_hi = e; a.li = li++;
            hipLaunchKernelGGL(mk_fwd, dim3(grid), dim3(NWAVES * 64), LDS_BYTES, stream, a);
            k = e; continue;
        }
        switch (k) {
        case 0:
            k_prep_w<<<nb((size_t)INW * D), 256, 0, stream>>>(w_in, nullptr, D, INW, INW, 1, nullptr, Win);
            k_prep_w<<<nb((size_t)D * 512), 256, 0, stream>>>(w_attn_out, nullptr, 512, D, D, 0, nullptr, Wa);
            k_prep_w<<<nb((size_t)D * CW), 256, 0, stream>>>(w_conv_out, nullptr, CW, D, D, 0, nullptr, Wc);
            k_prep_w<<<nb((size_t)D * D), 256, 0, stream>>>(w_o, nullptr, D, D, D, 0, nullptr, Wo);
            k_prep_w<<<nb((size_t)2 * FF * D), 256, 0, stream>>>(w_gate, w_up, D, FF, 2 * FF, 2, norm2_g, Wgu);
            k_prep_w<<<nb((size_t)D * FF), 256, 0, stream>>>(w_down, nullptr, FF, D, D, 0, nullptr, Wd);
            k_rmsnorm_bf16<<<M / 4, 256, 0, stream>>>(x, norm1_g, Hb); break;
        case 1:
            k_gemm<EpQKV, false><<<dim3(3 * AW / 64, M / 64), 256, 0, stream>>>(Hb, Win, D, 0, 0, EpQKV{Qb});
            k_gemm<EpGLU, true><<<dim3(CW / 64, M / 64), 256, 0, stream>>>(Hb, Win, D, 3 * AW, 1, EpGLU{Cb});
            k_gemm<EpGate, false><<<dim3(2048 / 64, M / 64), 256, 0, stream>>>(Hb, Win, D, 3 * AW + 2 * CW, 0, EpGate{Gates, gate_b}); break;
        case 2:
            k_attn_naive<<<M * NH / 256, 256, 0, stream>>>(Qb, Kb, Vb, LSE);
            k_conv_naive<<<M, 256, 0, stream>>>(Cb, conv_w, conv_b, ln_g, ln_b, C2b); break;
        case 3: k_combine<<<M / 4, 256, 0, stream>>>(Qb, LSE, ATT); break;
        case 4:
            k_gemm<EpZA, false><<<dim3(D / 64, M / 64), 256, 0, stream>>>(ATT, Wa, 512, 0, 0, EpZA{Gates, ZA});
            k_gemm<EpZ, false><<<dim3(D / 64, M / 64), 256, 0, stream>>>(C2b, Wc, CW, 0, 0, EpZ{Gates, ZA, Zb}); break;
        case 5:
            k_gemm<EpX1, false><<<dim3(D / 64, M / 64), 256, 0, stream>>>(Zb, Wo, D, 0, 0, EpX1{x, out, X1B});
            k_rowss<<<M / 4, 256, 0, stream>>>(out, SS1); break;
        case 6: k_gemm<EpHid, true><<<dim3(FF / 64, M / 64), 256, 0, stream>>>(X1B, Wgu, D, 0, 1, EpHid{SS1, HID}); break;
        case 7:
            k_gemm<EpX2, false><<<dim3(D / 64, M / 64), 256, 0, stream>>>(HID, Wd, FF, 0, 0, EpX2{out});
            k_rowss<<<M / 4, 256, 0, stream>>>(out, SS2); break;
        case 8: k_final<<<M / 4, 256, 0, stream>>>(out, SS2, norm_f_g); break;
        }
        ++k;
    }
}
```
